# Optimizing an MI355X kernel written in HIP

```python
import math
import jax, jax.numpy as jnp
from jax import lax
import numpy as np

D_MODEL = 1024
BATCH = 4
SEQ = 8192
DEPTH = 2

CHUNK = 64
GM_BLOCK = 128
GM_WIDTH = D_MODEL // 2
GM_GROUPS = 4
GM_GROUP_CH = GM_WIDTH // GM_GROUPS
MLA_HEADS = 8
MLA_Q_RANK = D_MODEL // 4
MLA_KV_RANK = D_MODEL // 8
MLA_NOPE = 64
MLA_ROPE = 32
MLA_V = 64
MLA_WIDTH = MLA_HEADS * MLA_V
Q_BLOCK = 128
ROPE_BASE = 10000.0
LRU_WIDTH = D_MODEL // 2
LRU_BLOCKS = 8
LRU_BLOCK_W = LRU_WIDTH // LRU_BLOCKS
CONV_W = 4
LRU_C = 8.0
N_BRANCH = 3
BRANCH_W = GM_WIDTH
D_FF = 4 * D_MODEL
ALPHA = (2.0 * DEPTH) ** 0.25
BETA = (8.0 * DEPTH) ** -0.25
LN_EPS = 1e-5
RMS_EPS = 1e-6
OFF_GM = 0
OFF_QLAT = OFF_GM + 2 * GM_WIDTH
OFF_KVLAT = OFF_QLAT + MLA_Q_RANK
OFF_KROPE = OFF_KVLAT + MLA_KV_RANK
OFF_LRU_X = OFF_KROPE + MLA_ROPE
OFF_LRU_G = OFF_LRU_X + LRU_WIDTH
OFF_GATE = OFF_LRU_G + LRU_WIDTH
N_IN = OFF_GATE + N_BRANCH * D_MODEL

kernel_name = 'hybrid_gmlp_mla_rglru_deepnorm_adaln'


def layer_norm(x):
    xf = x.astype(jnp.float32)
    mu = jnp.mean(xf, axis=-1, keepdims=True)
    var = jnp.mean(jnp.square(xf - mu), axis=-1, keepdims=True)
    return ((xf - mu) * lax.rsqrt(var + LN_EPS)).astype(x.dtype)


def rms_norm(x, g):
    xf = x.astype(jnp.float32)
    y = xf * lax.rsqrt(jnp.mean(jnp.square(xf), axis=-1, keepdims=True) + RMS_EPS)
    return y.astype(x.dtype) * g


def rope_tables(seq, dtype):
    pos = jnp.arange(seq, dtype=jnp.float32)
    inv = ROPE_BASE ** (-jnp.arange(0, MLA_ROPE, 2, dtype=jnp.float32) / MLA_ROPE)
    ang = pos[:, None] * inv[None, :]
    return jnp.cos(ang).astype(dtype), jnp.sin(ang).astype(dtype)


def apply_rope(x, cos, sin):
    x1, x2 = jnp.split(x, 2, axis=-1)
    return jnp.concatenate([x1 * cos - x2 * sin, x2 * cos + x1 * sin], axis=-1)


def gmlp_mix(z, ln_g, ln_b, ws, bs):
    B, S, _ = z.shape
    z = jax.nn.gelu(z)
    u, v = jnp.split(z, 2, axis=-1)
    v = layer_norm(v) * ln_g + ln_b
    v = v.reshape(B, S // GM_BLOCK, GM_BLOCK, GM_GROUPS, GM_GROUP_CH)
    chunk_id = jnp.arange(GM_BLOCK) // CHUNK
    mask = chunk_id[:, None] >= chunk_id[None, :]
    w = jnp.where(mask[None], ws, 0.0)
    f = jnp.einsum('gij,bnjgc->bnigc', w, v) + bs.T[None, None, :, :, None]
    return u * f.reshape(B, S, GM_WIDTH)


def mla_mix(q_lat, kv_lat, k_rope, q_norm_g, w_uq, kv_norm_g, w_ukv, cos, sin):
    B, S, _ = q_lat.shape
    q = (rms_norm(q_lat, q_norm_g) @ w_uq).reshape(B, S, MLA_HEADS, MLA_NOPE + MLA_ROPE)
    q_nope = q[..., :MLA_NOPE]
    q_rope = apply_rope(q[..., MLA_NOPE:], cos[:, None, :], sin[:, None, :])
    kv = (rms_norm(kv_lat, kv_norm_g) @ w_ukv).reshape(B, S, MLA_HEADS, MLA_NOPE + MLA_V)
    k_nope = kv[..., :MLA_NOPE]
    v = kv[..., MLA_NOPE:]
    k_rope = apply_rope(k_rope, cos, sin)
    scale = (MLA_NOPE + MLA_ROPE) ** -0.5
    nq = S // Q_BLOCK
    k_chunk = jnp.arange(S) // CHUNK

    def to_blocks(t):
        return t.reshape(B, nq, Q_BLOCK, *t.shape[2:]).swapaxes(0, 1)

    def attend(args):
        qn, qr, blk = args
        s = (jnp.einsum('bqhd,bkhd->bhqk', qn, k_nope)
             + jnp.einsum('bqhr,bkr->bhqk', qr, k_rope)).astype(jnp.float32) * scale
        q_chunk = (blk * Q_BLOCK + jnp.arange(Q_BLOCK)) // CHUNK
        mask = k_chunk[None, :] <= q_chunk[:, None]
        s = jnp.where(mask[None, None], s, -jnp.inf)
        p = jax.nn.softmax(s, axis=-1).astype(v.dtype)
        return jnp.einsum('bhqk,bkhd->bqhd', p, v)

    o = lax.map(attend, (to_blocks(q_nope), to_blocks(q_rope), jnp.arange(nq)))
    return o.swapaxes(0, 1).reshape(B, S, MLA_WIDTH)


def rglru_mix(xb, gb, conv_w, conv_b, wr, br, wi, bi, lam):
    B, S, _ = xb.shape
    xp = jnp.pad(xb, ((0, 0), (CONV_W - 1, 0), (0, 0)))
    xc = conv_b + sum(xp[:, k:k + S] * conv_w[k] for k in range(CONV_W))
    xblk = xc.reshape(B, S, LRU_BLOCKS, LRU_BLOCK_W)
    r = jax.nn.sigmoid(jnp.einsum('bsnc,ncd->bsnd', xblk, wr).reshape(B, S, LRU_WIDTH) + br)
    i = jax.nn.sigmoid(jnp.einsum('bsnc,ncd->bsnd', xblk, wi).reshape(B, S, LRU_WIDTH) + bi)
    log_a = -LRU_C * r.astype(jnp.float32) * jax.nn.softplus(-lam.astype(jnp.float32))
    a = jnp.exp(log_a)
    b = jnp.sqrt(-jnp.expm1(2.0 * log_a)) * (i * xc).astype(jnp.float32)

    def combine(lhs, rhs):
        a1, b1 = lhs
        a2, b2 = rhs
        return a1 * a2, a2 * b1 + b2

    _, h = lax.associative_scan(combine, (a, b), axis=1)
    return h.astype(xb.dtype) * jax.nn.gelu(gb)


def setup_inputs(seed: int = 0) -> dict:
    key = jax.random.key(seed)
    ks = iter(jax.random.split(key, 40))
    L = DEPTH

    def nrm(shape, scale):
        return jax.random.normal(next(ks), shape, jnp.float32) * scale

    a0 = jax.random.uniform(next(ks), (L, LRU_WIDTH), jnp.float32, 0.9, 0.999)
    return dict(
        x=nrm((BATCH, SEQ, D_MODEL), 1.0),
        c=nrm((BATCH, D_MODEL), 1.0),
        ada_w=nrm((L, D_MODEL, 6 * D_MODEL), 0.1 * D_MODEL ** -0.5),
        ada_b=nrm((L, 6 * D_MODEL), 0.01),
        in_w=nrm((L, D_MODEL, N_IN), D_MODEL ** -0.5),
        in_b=nrm((L, N_IN), 0.01),
        gm_ln_g=1.0 + nrm((L, GM_WIDTH), 0.05),
        gm_ln_b=nrm((L, GM_WIDTH), 0.01),
        gm_ws=nrm((L, GM_GROUPS, GM_BLOCK, GM_BLOCK), GM_BLOCK ** -0.5),
        gm_bs=1.0 + nrm((L, GM_GROUPS, GM_BLOCK), 0.05),
        mla_qnorm_g=1.0 + nrm((L, MLA_Q_RANK), 0.05),
        mla_wuq=nrm((L, MLA_Q_RANK, MLA_HEADS * (MLA_NOPE + MLA_ROPE)), MLA_Q_RANK ** -0.5),
        mla_kvnorm_g=1.0 + nrm((L, MLA_KV_RANK), 0.05),
        mla_wukv=nrm((L, MLA_KV_RANK, MLA_HEADS * (MLA_NOPE + MLA_V)), MLA_KV_RANK ** -0.5),
        lru_conv_w=nrm((L, CONV_W, LRU_WIDTH), CONV_W ** -0.5),
        lru_conv_b=nrm((L, LRU_WIDTH), 0.01),
        lru_wr=nrm((L, LRU_BLOCKS, LRU_BLOCK_W, LRU_BLOCK_W), LRU_BLOCK_W ** -0.5),
        lru_br=nrm((L, LRU_WIDTH), 0.01),
        lru_wi=nrm((L, LRU_BLOCKS, LRU_BLOCK_W, LRU_BLOCK_W), LRU_BLOCK_W ** -0.5),
        lru_bi=nrm((L, LRU_WIDTH), 0.01),
        lru_lambda=jnp.log(a0) - jnp.log1p(-a0),
        branch_w=nrm((L, N_BRANCH, BRANCH_W, D_MODEL), BETA * BRANCH_W ** -0.5),
        mix_out_w=nrm((L, D_MODEL, D_MODEL), BETA * D_MODEL ** -0.5),
        ffn_w1=nrm((L, D_MODEL, D_FF), D_MODEL ** -0.5),
        ffn_b1=nrm((L, D_FF), 0.01),
        ffn_w2=nrm((L, D_FF, D_MODEL), BETA * D_FF ** -0.5),
        ffn_b2=nrm((L, D_MODEL), 0.01),
        ln_g=1.0 + nrm((L, 2, D_MODEL), 0.05),
        ln_b=nrm((L, 2, D_MODEL), 0.01),
    )


def reference(x, c, ada_w, ada_b, in_w, in_b, gm_ln_g, gm_ln_b, gm_ws, gm_bs,
              mla_qnorm_g, mla_wuq, mla_kvnorm_g, mla_wukv,
              lru_conv_w, lru_conv_b, lru_wr, lru_br, lru_wi, lru_bi, lru_lambda,
              branch_w, mix_out_w, ffn_w1, ffn_b1, ffn_w2, ffn_b2, ln_g, ln_b):
    B, S, D = x.shape
    cos, sin = rope_tables(S, x.dtype)
    c_act = jax.nn.silu(c)
    for l in range(DEPTH):
        mod = (c_act @ ada_w[l] + ada_b[l])[:, None, :]
        sh1, sc1, g1, sh2, sc2, g2 = jnp.split(mod, 6, axis=-1)
        h = layer_norm(x) * (1.0 + sc1) + sh1
        z = h @ in_w[l] + in_b[l]
        y_a = gmlp_mix(z[..., OFF_GM:OFF_QLAT], gm_ln_g[l], gm_ln_b[l], gm_ws[l], gm_bs[l])
        y_b = mla_mix(z[..., OFF_QLAT:OFF_KVLAT], z[..., OFF_KVLAT:OFF_KROPE],
                      z[..., OFF_KROPE:OFF_LRU_X], mla_qnorm_g[l], mla_wuq[l],
                      mla_kvnorm_g[l], mla_wukv[l], cos, sin)
        y_c = rglru_mix(z[..., OFF_LRU_X:OFF_LRU_G], z[..., OFF_LRU_G:OFF_GATE],
                        lru_conv_w[l], lru_conv_b[l], lru_wr[l], lru_br[l],
                        lru_wi[l], lru_bi[l], lru_lambda[l])
        gates = jax.nn.sigmoid(z[..., OFF_GATE:]).reshape(B, S, N_BRANCH, D)
        merged = sum(gates[:, :, n] * (y @ branch_w[l, n]) for n, y in enumerate((y_a, y_b, y_c)))
        mix = merged @ mix_out_w[l]
        x = layer_norm(ALPHA * x + (1.0 + g1) * mix) * ln_g[l, 0] + ln_b[l, 0]
        h = layer_norm(x) * (1.0 + sc2) + sh2
        f = jnp.square(jax.nn.relu(h @ ffn_w1[l] + ffn_b1[l])) @ ffn_w2[l] + ffn_b2[l]
        x = layer_norm(ALPHA * x + (1.0 + g2) * f) * ln_g[l, 1] + ln_b[l, 1]
    return x
```

```cpp
#include <hip/hip_runtime.h>
#include <hip/hip_cooperative_groups.h>
#include <cstdio>
#include <cstdint>
namespace cg = cooperative_groups;

#define LAS __attribute__((address_space(3)))
typedef unsigned short bf16_t;
typedef short bf16x8 __attribute__((ext_vector_type(8)));
typedef float f32x4 __attribute__((ext_vector_type(4)));
typedef float f32x2 __attribute__((ext_vector_type(2)));
typedef unsigned u32x4 __attribute__((ext_vector_type(4)));
typedef unsigned u32x2 __attribute__((ext_vector_type(2)));

constexpr int NBATCH = 4, SEQ = 8192, T = NBATCH * SEQ, DM = 1024, NIN = 5536, ZP = 5632, FF = 4096;
constexpr int NUP = 1792, KUP = 384;
constexpr float ALPHA = 1.4142135623730951f;
constexpr float QSCALE = 0.10206207261596575f * 1.4426950408889634f;
constexpr int ZC_V = 512, ZC_QLAT = 1024, ZC_KVLAT = 1280, ZC_KROPE = 1408, ZC_YB = 1024, ZC_LRUX = 1536, ZC_KN = 1536, ZC_LRUG = 2048, ZC_GATE = 2560;
constexpr size_t MiB = 1u << 20;
constexpr size_t WS_MOD = 0, WS_BIASP = 262144, WS_ROPE = 1 * MiB, WS_BAR = 524288, WS_LRUS = 2 * MiB, WS_LRUW = 4 * MiB, WS_GMW = 5 * MiB, WS_STAT = 6 * MiB, WS_WIN = 8 * MiB, WS_WUP = 30 * MiB, WS_WBR = 33 * MiB, WS_WMIX = 39 * MiB,
                 WS_W1 = 43 * MiB, WS_W2 = 59 * MiB, WS_H = 76 * MiB, WS_Z = 140 * MiB, WS_END = 492 * MiB;
constexpr int LDS_BYTES = 147456;
constexpr int NTHREADS = 512;

__device__ __forceinline__ float bf2f(unsigned u) { return __builtin_bit_cast(float, u << 16); }
__device__ __forceinline__ float bflo(unsigned u) { return __builtin_bit_cast(float, u << 16); }
__device__ __forceinline__ float bfhi(unsigned u) { return __builtin_bit_cast(float, u & 0xffff0000u); }
__device__ __forceinline__ unsigned f2bf(float f) { unsigned u = __builtin_bit_cast(unsigned, f); return (u + 0x7fffu + ((u >> 16) & 1u)) >> 16; }
__device__ __forceinline__ unsigned pk2(float lo, float hi) { return f2bf(lo) | (f2bf(hi) << 16); }
__device__ __forceinline__ float sigmoidf_(float x) { return __builtin_amdgcn_rcpf(1.f + __builtin_amdgcn_exp2f(-1.4426950408889634f * x)); }
__device__ __forceinline__ float gelu_t(float x) { const float u = x * (-2.3022081986f - 0.1029432404f * x * x); return x * __builtin_amdgcn_rcpf(1.f + __builtin_amdgcn_exp2f(u)); }
template <int CTRL> __device__ __forceinline__ float dpp_mov(float v) {
    return __builtin_bit_cast(float, __builtin_amdgcn_update_dpp(__builtin_bit_cast(int, v), __builtin_bit_cast(int, v), CTRL, 0xF, 0xF, false));
}
__device__ __forceinline__ float xor16_sum(float v) { const u32x2 r = __builtin_amdgcn_permlane16_swap(__builtin_bit_cast(unsigned, v), __builtin_bit_cast(unsigned, v), false, false); return __builtin_bit_cast(float, r.x) + __builtin_bit_cast(float, r.y); }
__device__ __forceinline__ float xor32_sum(float v) { const u32x2 r = __builtin_amdgcn_permlane32_swap(__builtin_bit_cast(unsigned, v), __builtin_bit_cast(unsigned, v), false, false); return __builtin_bit_cast(float, r.x) + __builtin_bit_cast(float, r.y); }
__device__ __forceinline__ float xor32_max(float v) { const u32x2 r = __builtin_amdgcn_permlane32_swap(__builtin_bit_cast(unsigned, v), __builtin_bit_cast(unsigned, v), false, false); return fmaxf(__builtin_bit_cast(float, r.x), __builtin_bit_cast(float, r.y)); }
__device__ __forceinline__ float wave_sum(float v) {
    v += dpp_mov<0xB1>(v);
    v += dpp_mov<0x4E>(v);
    v += dpp_mov<0x141>(v);
    v += dpp_mov<0x140>(v);
    const int b = __builtin_bit_cast(int, v);
    const float r0 = __builtin_bit_cast(float, __builtin_amdgcn_readlane(b, 0)), r1 = __builtin_bit_cast(float, __builtin_amdgcn_readlane(b, 16));
    const float r2 = __builtin_bit_cast(float, __builtin_amdgcn_readlane(b, 32)), r3 = __builtin_bit_cast(float, __builtin_amdgcn_readlane(b, 48));
    return (r0 + r1) + (r2 + r3);
}

namespace pg8 {
constexpr int BM = 256, BK = 64, HALF = 128, HTB = HALF * BK * 2, NXCD = 8, WGM = 8;
__device__ __forceinline__ int lds_byte(int r, int c) { const int st = (r >> 4) * 2 + (c >> 5), rr = r & 15, cc = c & 31, ob = rr * 64 + cc * 2; return st * 1024 + (ob ^ (((ob >> 9) & 1) << 5)); }
__device__ __forceinline__ void stage_rc(int b, int& R, int& C) { const int st = b / 1024, sb = b % 1024, swz = sb ^ (((sb >> 9) & 1) << 5); R = (st >> 1) * 16 + swz / 64; C = (st & 1) * 32 + (swz % 64) / 2; }
__device__ __forceinline__ int perm32(int rho) { const int n = rho >> 4, i = rho & 15; return 8 * (i >> 2) + 4 * n + (i & 3); }

struct Unit { int pm, pn, acol; };
struct Gemm { const bf16_t* A; const bf16_t* Bt; int lda, K; };

struct StaticOrder {
    int nM, nN, nwg, G, c;
    __device__ void init(int M, int N, int G_, int c_) { nM = M / BM; nN = N / BM; nwg = nM * nN; G = G_; c = c_; }
    __device__ bool next(int i, Unit& u) const {
        const long L = (long)i * G + c; if (L >= nwg) return false;
        int wgid = (int)L; { const int q = nwg / NXCD, r = nwg % NXCD, xcd = wgid % NXCD, off = wgid / NXCD; wgid = (xcd < r ? xcd * (q + 1) : r * (q + 1) + (xcd - r) * q) + off; }
        const int nig = WGM * nN, gid = wgid / nig, fm = gid * WGM, gsz = (nM - fm) < WGM ? (nM - fm) : WGM;
        u.pm = fm + ((wgid % nig) % gsz); u.pn = (wgid % nig) / gsz; u.acol = 0; return true;
    }
};
struct BranchOrder {
    int G, c;
    __device__ bool next(int i, Unit& u) const {
        const int grp = (i / 3) * G + c; if (grp >= (T / 256) * 4) return false;
        const int n = i % 3; u.pm = grp >> 2; u.pn = n * 4 + (grp & 3); u.acol = n * 1024; return true;
    }
};

__device__ __forceinline__ unsigned cvt_pk_bf16(float lo, float hi) { unsigned r; asm volatile("v_cvt_pk_bf16_f32 %0, %1, %2" : "=v"(r) : "v"(lo), "v"(hi)); return r; }

#define EPI_LOOP_BEGIN \
    _Pragma("unroll") for (int ai = 0; ai < 2; ++ai) _Pragma("unroll") for (int m = 0; m < 4; ++m) { const int row = u.pm * BM + ai * HALF + wr * 64 + m * 16 + fr; \
    _Pragma("unroll") for (int bj = 0; bj < 2; ++bj) { const int cl = bj * HALF + wc * 32 + 8 * fq; f32x4 v0 = acc[ai][bj][m][0], v1 = acc[ai][bj][m][1];
#define EPI_LOOP_END } }

struct EpiZ {
    bf16_t* Z; const float* bias;
    __device__ __forceinline__ void operator()(const f32x4 (&acc)[2][2][4][2], const Unit& u, int wr, int wc, int fr, int fq) const {
        const int pn = u.pn; const int act = (pn < 4 || pn == 8 || pn == 9) ? 1 : (pn >= 10 ? 2 : 0);
        EPI_LOOP_BEGIN
            const int col = pn * BM + cl; const f32x4 b0 = *(const f32x4*)(bias + col), b1 = *(const f32x4*)(bias + col + 4);
            v0 = v0 + b0; v1 = v1 + b1;
            if (act == 1) {
#pragma unroll
                for (int e = 0; e < 4; ++e) { v0[e] = gelu_t(v0[e]); v1[e] = gelu_t(v1[e]); }
            } else if (act == 2) {
#pragma unroll
                for (int e = 0; e < 4; ++e) { v0[e] = sigmoidf_(v0[e]); v1[e] = sigmoidf_(v1[e]); }
            }
            u32x4 w; w.x = cvt_pk_bf16(v0[0], v0[1]); w.y = cvt_pk_bf16(v0[2], v0[3]); w.z = cvt_pk_bf16(v1[0], v1[1]); w.w = cvt_pk_bf16(v1[2], v1[3]);
            *(u32x4*)(Z + (size_t)row * ZP + col) = w;
        EPI_LOOP_END
    }
};
struct EpiUp {
    bf16_t* Hb; bf16_t* Z;
    __device__ __forceinline__ void operator()(const f32x4 (&acc)[2][2][4][2], const Unit& u, int wr, int wc, int fr, int fq) const {
        const int pn = u.pn;
        if (pn < 3) {
            bf16_t* base = Hb + pn * BM;
            EPI_LOOP_BEGIN
                v0 = v0 * QSCALE; v1 = v1 * QSCALE;
                u32x4 w; w.x = cvt_pk_bf16(v0[0], v0[1]); w.y = cvt_pk_bf16(v0[2], v0[3]); w.z = cvt_pk_bf16(v1[0], v1[1]); w.w = cvt_pk_bf16(v1[2], v1[3]);
                *(u32x4*)(base + (size_t)row * 1024 + cl) = w;
            EPI_LOOP_END
        } else {
            bf16_t* base = pn < 5 ? Z + ZC_KN + (pn - 3) * BM : Z + ZC_V + (pn - 5) * BM;
            EPI_LOOP_BEGIN
                u32x4 w; w.x = cvt_pk_bf16(v0[0], v0[1]); w.y = cvt_pk_bf16(v0[2], v0[3]); w.z = cvt_pk_bf16(v1[0], v1[1]); w.w = cvt_pk_bf16(v1[2], v1[3]);
                *(u32x4*)(base + (size_t)row * ZP + cl) = w;
            EPI_LOOP_END
        }
    }
};
struct EpiBranch {
    bf16_t* Mg; const bf16_t* Z;
    __device__ __forceinline__ void operator()(const f32x4 (&acc)[2][2][4][2], const Unit& u, int wr, int wc, int fr, int fq) const {
        const int n = u.pn >> 2, pnr = u.pn & 3;
        const int col0 = pnr * BM + wc * 32 + 8 * fq;
#pragma unroll
        for (int ai = 0; ai < 2; ++ai) {
            u32x4 g[4][2], o[4][2];
#pragma unroll
            for (int m = 0; m < 4; ++m)
#pragma unroll
                for (int bj = 0; bj < 2; ++bj) { const int row = u.pm * BM + ai * HALF + wr * 64 + m * 16 + fr, col = col0 + bj * HALF;
                    g[m][bj] = *(const u32x4*)(Z + (size_t)row * ZP + ZC_GATE + n * 1024 + col);
                    if (n > 0) o[m][bj] = *(const u32x4*)(Mg + (size_t)row * 1024 + col); }
#pragma unroll
            for (int m = 0; m < 4; ++m)
#pragma unroll
                for (int bj = 0; bj < 2; ++bj) { const int row = u.pm * BM + ai * HALF + wr * 64 + m * 16 + fr, col = col0 + bj * HALF;
                    f32x4 v0 = acc[ai][bj][m][0], v1 = acc[ai][bj][m][1]; const u32x4 gg = g[m][bj];
                    v0[0] *= bflo(gg.x); v0[1] *= bfhi(gg.x); v0[2] *= bflo(gg.y); v0[3] *= bfhi(gg.y); v1[0] *= bflo(gg.z); v1[1] *= bfhi(gg.z); v1[2] *= bflo(gg.w); v1[3] *= bfhi(gg.w);
                    if (n > 0) { const u32x4 oo = o[m][bj];
                        v0[0] += bflo(oo.x); v0[1] += bfhi(oo.x); v0[2] += bflo(oo.y); v0[3] += bfhi(oo.y); v1[0] += bflo(oo.z); v1[1] += bfhi(oo.z); v1[2] += bflo(oo.w); v1[3] += bfhi(oo.w); }
                    u32x4 w; w.x = cvt_pk_bf16(v0[0], v0[1]); w.y = cvt_pk_bf16(v0[2], v0[3]); w.z = cvt_pk_bf16(v1[0], v1[1]); w.w = cvt_pk_bf16(v1[2], v1[3]);
                    *(u32x4*)(Mg + (size_t)row * 1024 + col) = w; }
        }
    }
};
struct EpiRes {
    const float* Xin; float* Xout; const float* gmod; const float* bias;
    const float* stat; const float* lg; const float* lb;
    __device__ __forceinline__ void operator()(const f32x4 (&acc)[2][2][4][2], const Unit& u, int wr, int wc, int fr, int fq) const {
        const float* gm = gmod + (u.pm >> 5) * 6144;
        const int col0 = u.pn * BM + wc * 32 + 8 * fq;
#pragma unroll
        for (int ai = 0; ai < 2; ++ai)
#pragma unroll
            for (int mh = 0; mh < 2; ++mh) {
                f32x4 xa[2][2], xb[2][2]; f32x2 sm[2];
#pragma unroll
                for (int mm = 0; mm < 2; ++mm) { const int row = u.pm * BM + ai * HALF + wr * 64 + (2 * mh + mm) * 16 + fr;
                    sm[mm] = stat ? *(const f32x2*)(stat + 2 * row) : (f32x2){0.f, 1.f};
#pragma unroll
                    for (int bj = 0; bj < 2; ++bj) { const int col = col0 + bj * HALF;
                        xa[mm][bj] = *(const f32x4*)(Xin + (size_t)row * DM + col); xb[mm][bj] = *(const f32x4*)(Xin + (size_t)row * DM + col + 4); } }
#pragma unroll
                for (int bj = 0; bj < 2; ++bj) { const int col = col0 + bj * HALF;
                    f32x4 g0 = *(const f32x4*)(gm + col) + 1.f, g1 = *(const f32x4*)(gm + col + 4) + 1.f;
                    f32x4 b0 = (f32x4){0.f, 0.f, 0.f, 0.f}, b1 = b0;
                    if (bias) { b0 = *(const f32x4*)(bias + col); b1 = *(const f32x4*)(bias + col + 4); }
                    f32x4 l0 = (f32x4){1.f, 1.f, 1.f, 1.f}, l1 = l0, c0 = (f32x4){0.f, 0.f, 0.f, 0.f}, c1 = c0;
                    if (stat) { l0 = *(const f32x4*)(lg + col); l1 = *(const f32x4*)(lg + col + 4); c0 = *(const f32x4*)(lb + col); c1 = *(const f32x4*)(lb + col + 4); }
#pragma unroll
                    for (int mm = 0; mm < 2; ++mm) { const int m = 2 * mh + mm; const int row = u.pm * BM + ai * HALF + wr * 64 + m * 16 + fr;
                        f32x4 x0 = xa[mm][bj], x1 = xb[mm][bj];
                        if (stat) { x0 = (x0 - sm[mm].x) * sm[mm].y * l0 + c0; x1 = (x1 - sm[mm].x) * sm[mm].y * l1 + c1; }
                        *(f32x4*)(Xout + (size_t)row * DM + col) = x0 * ALPHA + g0 * (acc[ai][bj][m][0] + b0);
                        *(f32x4*)(Xout + (size_t)row * DM + col + 4) = x1 * ALPHA + g1 * (acc[ai][bj][m][1] + b1); } }
            }
    }
};
struct EpiFF1 {
    bf16_t* F1; const float* bias;
    __device__ __forceinline__ void operator()(const f32x4 (&acc)[2][2][4][2], const Unit& u, int wr, int wc, int fr, int fq) const {
        EPI_LOOP_BEGIN
            const int col = u.pn * BM + cl;
            v0 = v0 + *(const f32x4*)(bias + col); v1 = v1 + *(const f32x4*)(bias + col + 4);
#pragma unroll
            for (int e = 0; e < 4; ++e) { const float a = fmaxf(v0[e], 0.f), b = fmaxf(v1[e], 0.f); v0[e] = a * a; v1[e] = b * b; }
            u32x4 w; w.x = cvt_pk_bf16(v0[0], v0[1]); w.y = cvt_pk_bf16(v0[2], v0[3]); w.z = cvt_pk_bf16(v1[0], v1[1]); w.w = cvt_pk_bf16(v1[2], v1[3]);
            *(u32x4*)(F1 + (size_t)row * ZP + col) = w;
        EPI_LOOP_END
    }
};

template <class Epi, class Sched>
__device__ __forceinline__ void gemm_phase(LAS unsigned char* lds, const Gemm g, const Sched& S, const Epi& E) {
    int tid_ = threadIdx.x; asm volatile("" : "+v"(tid_));
    const int tid = tid_, wid = __builtin_amdgcn_readfirstlane(tid >> 6), lane = tid & 63, wr = wid >> 2, wc = wid & 3, fr = lane & 15, fq = lane >> 4;
    const int K = g.K, nt = K / BK, lda = g.lda;
    unsigned voffA[2], voffB[2];
#pragma unroll
    for (int i = 0; i < 2; ++i) { int R, C; stage_rc(tid * 16 + i * 8192, R, C); const int Rb = (R & ~31) + perm32(R & 31);
        voffA[i] = (unsigned)(R * lda + C) * 2u; voffB[i] = (unsigned)(Rb * K + C) * 2u; }
    const size_t kstep = (size_t)(BK * 2);
    const size_t hstepA = (size_t)HALF * lda * 2, hstepB = (size_t)HALF * K * 2;
    const size_t tstepA = 2 * hstepA, tstepB = 2 * hstepB;
    const unsigned ldsw = (unsigned)wid * 1024u;
    const int aoff = lds_byte(wr * 64 + fr, fq * 8), boff = lds_byte(wc * 32 + fr, fq * 8);
#define PG8_SA(b, h) (((b) * 2 + (h)) * HTB)
#define PG8_SB(b, h) ((4 + (b) * 2 + (h)) * HTB)
#define PG8_STAGE(bufoff, gbase, voff) do { _Pragma("unroll") for (int _i = 0; _i < 2; ++_i) \
        __builtin_amdgcn_global_load_lds((const unsigned*)((const char*)(gbase) + (voff)[_i]), (LAS unsigned*)(lds + (bufoff) + ldsw + _i * 8192), 16, 0, 0); } while (0)
#define PG8_LDA(dst, b, h) do { _Pragma("unroll") for (int m = 0; m < 4; ++m) _Pragma("unroll") for (int k = 0; k < 2; ++k) dst[m][k] = *(const LAS bf16x8*)(lds + PG8_SA(b, h) + aoff + m * 2048 + k * 1024); } while (0)
#define PG8_LDB(dst, b, h) do { _Pragma("unroll") for (int n = 0; n < 2; ++n) _Pragma("unroll") for (int k = 0; k < 2; ++k) dst[n][k] = *(const LAS bf16x8*)(lds + PG8_SB(b, h) + boff + n * 2048 + k * 1024); } while (0)
#define PG8_MMA(ai, bj, At, Bt) do { __builtin_amdgcn_s_setprio(1); _Pragma("unroll") for (int m = 0; m < 4; ++m) _Pragma("unroll") for (int n = 0; n < 2; ++n) _Pragma("unroll") for (int k = 0; k < 2; ++k) \
        acc[ai][bj][m][n] = __builtin_amdgcn_mfma_f32_16x16x32_bf16(Bt[n][k], At[m][k], acc[ai][bj][m][n], 0, 0, 0); __builtin_amdgcn_s_setprio(0); } while (0)
#define PG8_WAIT_V(n) asm volatile("s_waitcnt vmcnt(" #n ")" ::: "memory")
#define PG8_WAIT_L(n) asm volatile("s_waitcnt lgkmcnt(" #n ")" ::: "memory")
#define PG8_BAR __builtin_amdgcn_s_barrier()
#define PG8_SCHED __builtin_amdgcn_sched_barrier(0)
    Unit cur, nxt; int ui = 0;
    if (!S.next(0, cur)) return;
    f32x4 acc[2][2][4][2];
#pragma unroll
    for (int a = 0; a < 2; ++a)
#pragma unroll
        for (int b = 0; b < 2; ++b)
#pragma unroll
            for (int m = 0; m < 4; ++m)
#pragma unroll
                for (int n = 0; n < 2; ++n) acc[a][b][m][n] = (f32x4){0.f, 0.f, 0.f, 0.f};
    bf16x8 At[4][2], B0[2][2], B1[2][2];
    const char* cA = (const char*)g.A + (size_t)cur.pm * tstepA + (size_t)cur.acol * 2; const char* cB = (const char*)g.Bt + (size_t)cur.pn * tstepB;
    PG8_STAGE(PG8_SB(0, 0), cB, voffB); PG8_STAGE(PG8_SB(0, 1), cB + hstepB, voffB); PG8_STAGE(PG8_SA(0, 0), cA, voffA); PG8_STAGE(PG8_SA(0, 1), cA + hstepA, voffA);
    if (wr == 1) PG8_BAR;
    PG8_WAIT_V(2); PG8_BAR;
    PG8_STAGE(PG8_SB(1, 0), cB + kstep, voffB); PG8_STAGE(PG8_SA(1, 0), cA + kstep, voffA); PG8_STAGE(PG8_SB(1, 1), cB + hstepB + kstep, voffB);
    PG8_WAIT_V(6); PG8_BAR;
    for (;;) {
        const bool has_next = S.next(ui + 1, nxt);
        const char* nA = has_next ? (const char*)g.A + (size_t)nxt.pm * tstepA + (size_t)nxt.acol * 2 : cA; const char* nB = has_next ? (const char*)g.Bt + (size_t)nxt.pn * tstepB : cB;
#pragma unroll 1
        for (int t = 0; t < nt; t += 2) {
            const bool last = (t == nt - 2);
            const char* a1 = cA + (size_t)(t + 1) * kstep;
            const char* a2 = last ? nA : cA + (size_t)(t + 2) * kstep; const char* b2 = last ? nB : cB + (size_t)(t + 2) * kstep;
            const char* a3 = a2 + kstep; const char* b3 = b2 + kstep;
            PG8_LDB(B0, 0, 0); PG8_LDB(B1, 0, 1); PG8_SCHED; PG8_LDA(At, 0, 0); PG8_STAGE(PG8_SA(1, 1), a1 + hstepA, voffA);
            PG8_WAIT_V(8); PG8_WAIT_L(0); PG8_BAR; PG8_MMA(0, 0, At, B0); PG8_MMA(0, 1, At, B1); PG8_BAR; PG8_SCHED;
            PG8_LDA(At, 0, 1); PG8_STAGE(PG8_SB(0, 0), b2, voffB); PG8_STAGE(PG8_SB(0, 1), b2 + hstepB, voffB); PG8_STAGE(PG8_SA(0, 0), a2, voffA);
            PG8_WAIT_V(8); PG8_WAIT_L(0); PG8_BAR; PG8_MMA(1, 0, At, B0); PG8_MMA(1, 1, At, B1); PG8_BAR; PG8_SCHED;
            PG8_LDB(B0, 1, 0); PG8_LDB(B1, 1, 1); PG8_SCHED; PG8_LDA(At, 1, 0); PG8_STAGE(PG8_SA(0, 1), a2 + hstepA, voffA);
            PG8_WAIT_V(8); PG8_WAIT_L(0); PG8_BAR; PG8_MMA(0, 0, At, B0); PG8_MMA(0, 1, At, B1); PG8_BAR; PG8_SCHED;
            PG8_LDA(At, 1, 1); PG8_STAGE(PG8_SB(1, 0), b3, voffB); PG8_STAGE(PG8_SB(1, 1), b3 + hstepB, voffB); PG8_STAGE(PG8_SA(1, 0), a3, voffA);
            PG8_WAIT_V(8); PG8_WAIT_L(0); PG8_BAR; PG8_MMA(1, 0, At, B0); PG8_MMA(1, 1, At, B1); PG8_BAR; PG8_SCHED;
        }
        if (wr == 0) PG8_BAR;
        E(acc, cur, wr, wc, fr, fq);
        if (!has_next) break;
#pragma unroll
        for (int a = 0; a < 2; ++a)
#pragma unroll
            for (int b = 0; b < 2; ++b)
#pragma unroll
                for (int m = 0; m < 4; ++m)
#pragma unroll
                    for (int n = 0; n < 2; ++n) acc[a][b][m][n] = (f32x4){0.f, 0.f, 0.f, 0.f};
        cur = nxt; cA = nA; cB = nB; ++ui;
        if (wr == 1) PG8_BAR;
    }
    PG8_WAIT_V(0);
    PG8_BAR;
#undef PG8_SA
#undef PG8_SB
#undef PG8_STAGE
#undef PG8_LDA
#undef PG8_LDB
#undef PG8_MMA
#undef PG8_WAIT_V
#undef PG8_WAIT_L
#undef PG8_BAR
#undef PG8_SCHED
}
}

#define XB_TMO      128
#define XB_XCNT(j)  (256  + 64 * (j))
#define XB_XSUB(j)  (1280 + 64 * (j))
#define XB_XGEN(j)  (2304 + 64 * (j))
#define XB_TOP      3328
#define XB_TOPGEN   3392
#define XCD_BAR_WORDS 3456
#define XB_LSUB(j)  (3456 + 32 * (j))
#define XB_LGEN(j)  (3712 + 32 * (j))
#define XB_BAD      4000
#define XB_SPIN_CAP (1u << 18)

__device__ __forceinline__ unsigned xb_ld(unsigned* p)              { return __hip_atomic_load(p, __ATOMIC_RELAXED, __HIP_MEMORY_SCOPE_AGENT); }
__device__ __forceinline__ unsigned xb_add(unsigned* p, unsigned v) { return __hip_atomic_fetch_add(p, v, __ATOMIC_RELAXED, __HIP_MEMORY_SCOPE_AGENT); }
__device__ __forceinline__ unsigned xb_xcc_id() { return (unsigned)__builtin_amdgcn_s_getreg((3 << 11) | 20) & 0xFu; }
#define XB_SPIN(cond, bar) do { unsigned _sp = 0; while (cond) { __builtin_amdgcn_s_sleep(1); \
    if ((++_sp & 255u) == 0u) { if (xb_ld(&(bar)[XB_TMO])) break; if (_sp > XB_SPIN_CAP) { atomicAdd(&(bar)[XB_TMO], 1u); break; } } } } while (0)

struct XcdBarrier {
    unsigned* bar; unsigned x;
    volatile LAS unsigned* st;
};

__device__ __forceinline__ XcdBarrier xcd_barrier_post(unsigned* bar, volatile LAS unsigned* st) {
    XcdBarrier b; b.bar = bar; b.x = xb_xcc_id(); b.st = st;
    if (threadIdx.x == 0) (void)xb_add(&bar[XB_XCNT(b.x)], 1u);
    return b;
}
__device__ __forceinline__ void xcd_barrier_complete(unsigned* bar, unsigned x, unsigned& nloc, unsigned& nx) {
    const unsigned G = gridDim.x * gridDim.y * gridDim.z;
    unsigned sum, cnt, mine, sp = 0u;
    for (;;) {
        sum = 0u; cnt = 0u; mine = 0u;
#pragma unroll
        for (unsigned j = 0; j < 16; ++j) { const unsigned c = xb_ld(&bar[XB_XCNT(j)]); sum += c; cnt += (c > 0u) ? 1u : 0u; mine = (j == x) ? c : mine; }
        if (sum == G) break;
        __builtin_amdgcn_s_sleep(1);
        if ((++sp & 255u) == 0u) { if (xb_ld(&bar[XB_TMO])) break; if (sp > XB_SPIN_CAP) { atomicAdd(&bar[XB_TMO], 1u); break; } }
    }
    nloc = mine > 0u ? mine : 1u; nx = cnt > 0u ? cnt : 1u;
}

__device__ __forceinline__ void xcd_barrier(const XcdBarrier& b) {
    asm volatile("s_waitcnt vmcnt(0)" ::: "memory");
    __syncthreads();
    if (threadIdx.x == 0) {
        unsigned* bar = b.bar;
        __builtin_amdgcn_s_waitcnt(0);
        unsigned nloc = b.st[0], nx = b.st[1];
        if (nloc == 0u) { xcd_barrier_complete(bar, b.x, nloc, nx); b.st[0] = nloc; b.st[1] = nx; }
        const unsigned old = xb_add(&bar[XB_XSUB(b.x)], 1u);
        const unsigned gen = old / nloc;
        if (old + 1u == (gen + 1u) * nloc) {
            __builtin_amdgcn_fence(__ATOMIC_RELEASE, "agent");
            asm volatile("s_waitcnt vmcnt(0)" ::: "memory");
            const unsigned og = xb_add(&bar[XB_TOP], 1u);
            const unsigned tg = og / nx;
            if (og + 1u == (tg + 1u) * nx) xb_add(&bar[XB_TOPGEN], 1u);
            else XB_SPIN(xb_ld(&bar[XB_TOPGEN]) == tg, bar);
            __builtin_amdgcn_fence(__ATOMIC_ACQUIRE, "agent");
            xb_add(&bar[XB_XGEN(b.x)], 1u);
            asm volatile("s_waitcnt vmcnt(0)" ::: "memory");
        } else {
            XB_SPIN(xb_ld(&bar[XB_XGEN(b.x)]) == gen, bar);
            __builtin_amdgcn_fence(__ATOMIC_ACQUIRE, "agent");
            asm volatile("s_waitcnt vmcnt(0)" ::: "memory");
        }
    }
    __syncthreads();
}


__device__ __forceinline__ void xcd_local_barrier(const XcdBarrier& b) {
    asm volatile("s_waitcnt vmcnt(0)" ::: "memory");
    __syncthreads();
    if (threadIdx.x == 0) {
        unsigned* bar = b.bar;
        __builtin_amdgcn_s_waitcnt(0);
        const unsigned nloc = b.st[0] ? b.st[0] : 1u;
        const unsigned old = xb_add(&bar[XB_LSUB(b.x)], 1u);
        const unsigned gen = old / nloc;
        if (old + 1u == (gen + 1u) * nloc) xb_add(&bar[XB_LGEN(b.x)], 1u);
        else XB_SPIN(xb_ld(&bar[XB_LGEN(b.x)]) == gen, bar);
        __builtin_amdgcn_fence(__ATOMIC_ACQUIRE, "agent");
        asm volatile("s_waitcnt vmcnt(0)" ::: "memory");
    }
    __syncthreads();
}

struct Params { const float* in[29]; float* out; unsigned char* ws; int ph_lo, ph_hi; };
enum { I_X = 0, I_C, I_ADAW, I_ADAB, I_INW, I_INB, I_GMLNG, I_GMLNB, I_GMWS, I_GMBS, I_QNG, I_WUQ, I_KVNG, I_WUKV, I_CONVW, I_CONVB, I_WR, I_BR, I_WI, I_BI, I_LAM,
       I_BRW, I_MIXW, I_W1, I_B1, I_W2, I_B2, I_LNG, I_LNB };

__device__ __forceinline__ int map_in(int n) { return n < 1440 ? n : n + 96; }
__device__ __forceinline__ int map_q(int n) { const int h = n / 96, d = n % 96; if (d < 64) return n; const int i = d - 64; return h * 96 + 64 + (i < 16 ? 2 * i : 2 * (i - 16) + 1); }
__device__ __forceinline__ int map_kv(int n) { const int h = n >> 7, d = n & 127; return d < 64 ? 768 + h * 64 + d : 1280 + h * 64 + (d - 64); }
template <int MAPK>
__device__ __forceinline__ void transpose_item(const float* __restrict__ W, int N, bf16_t* WT, int ldk, int kofs, int rowbase, float* scr, int item, int lane) {
    const int nblk = N / 32, kb = item / nblk, nb = item % nblk, k0 = 64 * kb, n0 = 32 * nb;
#pragma unroll 8
    for (int i = 0; i < 32; ++i) { const int kk = 2 * i + (lane >> 5); scr[kk * 33 + (lane & 31)] = W[(size_t)(k0 + kk) * N + n0 + (lane & 31)]; }
    const int c = lane & 7;
#pragma unroll
    for (int j = 0; j < 4; ++j) { const int n = (lane >> 3) + 8 * j; const float* s = scr + (8 * c) * 33 + n;
        u32x4 o; o.x = pk2(s[0 * 33], s[1 * 33]); o.y = pk2(s[2 * 33], s[3 * 33]); o.z = pk2(s[4 * 33], s[5 * 33]); o.w = pk2(s[6 * 33], s[7 * 33]);
        const int nn = n0 + n; const int dr = rowbase + (MAPK == 1 ? map_in(nn) : MAPK == 2 ? map_q(nn) : MAPK == 3 ? map_kv(nn) : nn);
        *(u32x4*)(WT + (size_t)dr * ldk + kofs + k0 + 8 * c) = o; }
}

template <int PART>
__device__ __forceinline__ void prologue(const Params& p, unsigned char* lds) {
    const int tid = threadIdx.x, lane = tid & 63, wave = tid >> 6, G = gridDim.x;
    unsigned char* ws = p.ws;
    const int gw = blockIdx.x * 8 + wave, ngw = G * 8;
    float* scr = (float*)(lds + wave * 16384);
    constexpr int IT_IN = 16 * 173, IT_Q = 4 * 24, IT_KV = 2 * 32, IT_BR = 8 * 32, IT_MIX = 16 * 32, IT_W1 = 16 * 128, IT_W2 = 64 * 32;
    constexpr int IT_LAYER = IT_IN + IT_Q + IT_KV + 3 * IT_BR + IT_MIX + IT_W1 + IT_W2;
    if (PART == 1) for (int it = gw; it < 2 * IT_LAYER; it += ngw) {
        const int l = it / IT_LAYER; int r = it % IT_LAYER;
        bf16_t* win = (bf16_t*)(ws + WS_WIN) + (size_t)l * ZP * 1024; bf16_t* wup = (bf16_t*)(ws + WS_WUP) + (size_t)l * NUP * KUP;
        bf16_t* wbr = (bf16_t*)(ws + WS_WBR) + (size_t)l * 3072 * 512; bf16_t* wmix = (bf16_t*)(ws + WS_WMIX) + (size_t)l * 1024 * 1024;
        bf16_t* w1 = (bf16_t*)(ws + WS_W1) + (size_t)l * FF * 1024; bf16_t* w2 = (bf16_t*)(ws + WS_W2) + (size_t)l * 1024 * FF;
        if (r < IT_IN) { transpose_item<1>(p.in[I_INW] + (size_t)l * 1024 * NIN, NIN, win, 1024, 0, 0, scr, r, lane); continue; } r -= IT_IN;
        if (r < IT_Q) { transpose_item<2>(p.in[I_WUQ] + (size_t)l * 256 * 768, 768, wup, KUP, 0, 0, scr, r, lane); continue; } r -= IT_Q;
        if (r < IT_KV) { transpose_item<3>(p.in[I_WUKV] + (size_t)l * 128 * 1024, 1024, wup, KUP, 256, 0, scr, r, lane); continue; } r -= IT_KV;
        if (r < 3 * IT_BR) { const int n = r / IT_BR; transpose_item<0>(p.in[I_BRW] + ((size_t)l * 3 + n) * 512 * 1024, 1024, wbr, 512, 0, n * 1024, scr, r % IT_BR, lane); continue; } r -= 3 * IT_BR;
        if (r < IT_MIX) { transpose_item<0>(p.in[I_MIXW] + (size_t)l * 1024 * 1024, 1024, wmix, 1024, 0, 0, scr, r, lane); continue; } r -= IT_MIX;
        if (r < IT_W1) { transpose_item<0>(p.in[I_W1] + (size_t)l * 1024 * FF, FF, w1, 1024, 0, 0, scr, r, lane); continue; } r -= IT_W1;
        transpose_item<0>(p.in[I_W2] + (size_t)l * FF * 1024, 1024, w2, FF, 0, 0, scr, r, lane);
    }
    if (PART == 1) return;
    const int gt = blockIdx.x * NTHREADS + tid, ngt = G * NTHREADS;
    for (int i = gt; i < 2 * NUP * KUP; i += ngt) { const int l = i / (NUP * KUP), r = (i / KUP) % NUP, k = i % KUP;
        if ((r < 768) ? (k >= 256) : (k < 256)) ((bf16_t*)(ws + WS_WUP))[i] = 0; (void)l; }
    for (int i = gt; i < 2 * 96 * 1024; i += ngt) { const int l = i / (96 * 1024), r = i % (96 * 1024); ((bf16_t*)(ws + WS_WIN))[(size_t)l * ZP * 1024 + (size_t)1440 * 1024 + r] = 0; }
    for (int i = gt; i < 2 * 65536; i += ngt) { const int gi = i >> 16, r = i & 65535, ln = r >> 12, d = (r >> 6) & 63, c = r & 63;
        ((bf16_t*)(ws + WS_LRUW))[i] = (bf16_t)f2bf(p.in[gi ? I_WI : I_WR][(size_t)ln * 4096 + c * 64 + d]); }
    for (int i = gt; i < 2 * 4 * 128 * 128; i += ngt) { const int ii = (i >> 7) & 127, jj = i & 127;
        ((bf16_t*)(ws + WS_GMW))[i] = (ii < 64 && jj >= 64) ? (bf16_t)0 : (bf16_t)f2bf(p.in[I_GMWS][i]); }
    for (int i = gt; i < 2 * ZP; i += ngt) { const int l = i / ZP, c = i % ZP; float v = 0.f;
        if (c < 1440) v = p.in[I_INB][l * NIN + c]; else if (c >= 1536) v = p.in[I_INB][l * NIN + c - 96];
        ((float*)(ws + WS_BIASP))[i] = v; }
    for (int i = gt; i < SEQ * 16; i += ngt) { const int pos = i >> 4, j = i & 15;
        const float inv = (float)pow(10000.0, -(double)(2 * j) / 32.0); const float ang = (float)pos * inv;
        ((float*)(ws + WS_ROPE))[i] = (float)cos((double)ang); ((float*)(ws + WS_ROPE))[SEQ * 16 + i] = (float)sin((double)ang); }
    __syncthreads();
    float* sc = (float*)lds;
    float* red = (float*)(lds + 16384);
    for (int i = tid; i < 4096; i += NTHREADS) { const float v = p.in[I_C][i]; sc[i] = v / (1.f + __expf(-v)); }
    __syncthreads();
    for (int u = blockIdx.x; u < 2 * 96; u += G) {
        const int l = u / 96, n = (u % 96) * 64 + (tid & 63), kp = tid >> 6;
        const float* w = p.in[I_ADAW] + (size_t)l * 1024 * 6144 + n;
        float a0 = 0.f, a1 = 0.f, a2 = 0.f, a3 = 0.f;
        for (int k = kp * 128; k < kp * 128 + 128; ++k) { const float wv = w[(size_t)k * 6144]; a0 += sc[k] * wv; a1 += sc[1024 + k] * wv; a2 += sc[2048 + k] * wv; a3 += sc[3072 + k] * wv; }
        red[(kp * 4 + 0) * 64 + (tid & 63)] = a0; red[(kp * 4 + 1) * 64 + (tid & 63)] = a1; red[(kp * 4 + 2) * 64 + (tid & 63)] = a2; red[(kp * 4 + 3) * 64 + (tid & 63)] = a3;
        __syncthreads();
        if (tid < 256) { const int b = tid >> 6, c = tid & 63; float s = 0.f;
#pragma unroll
            for (int q = 0; q < 8; ++q) s += red[(q * 4 + b) * 64 + c];
            const int nn = (u % 96) * 64 + c;
            ((float*)(ws + WS_MOD))[(l * 4 + b) * 6144 + nn] = s + p.in[I_ADAB][l * 6144 + nn]; }
        __syncthreads();
    }
}

struct LnRows { int gw, ngw, rbase, rend; };
__device__ __forceinline__ void ln_pass(const float* src, float* dstx, const float* lg, const float* lb, const float* msc, const float* msh, bf16_t* Hout, float* statout, const LnRows R) {
    const int lane = threadIdx.x & 63;
    for (int row = R.rbase + R.gw; row < R.rend; row += R.ngw) {
        const f32x4* xr = (const f32x4*)(src + (size_t)row * DM) + lane;
        f32x4 v[4];
#pragma unroll
        for (int j = 0; j < 4; ++j) v[j] = xr[64 * j];
        if (lg) {
            float s = 0.f;
#pragma unroll
            for (int j = 0; j < 4; ++j) s += (v[j].x + v[j].y) + (v[j].z + v[j].w);
            const float mean = wave_sum(s) * (1.f / DM); float s2 = 0.f;
#pragma unroll
            for (int j = 0; j < 4; ++j) { v[j] = v[j] - mean; s2 += (v[j].x * v[j].x + v[j].y * v[j].y) + (v[j].z * v[j].z + v[j].w * v[j].w); }
            const float rstd = 1.f / sqrtf(wave_sum(s2) * (1.f / DM) + 1e-5f);
            if (statout && lane == 0) { statout[2 * row] = mean; statout[2 * row + 1] = rstd; }
#pragma unroll
            for (int j = 0; j < 4; ++j) { const f32x4 g = *((const f32x4*)lg + lane + 64 * j), b = *((const f32x4*)lb + lane + 64 * j); v[j] = v[j] * rstd * g + b;
                if (dstx) *((f32x4*)(dstx + (size_t)row * DM) + lane + 64 * j) = v[j]; }
        }
        if (Hout) {
            float s = 0.f;
#pragma unroll
            for (int j = 0; j < 4; ++j) s += (v[j].x + v[j].y) + (v[j].z + v[j].w);
            const float mean = wave_sum(s) * (1.f / DM); float s2 = 0.f;
#pragma unroll
            for (int j = 0; j < 4; ++j) { v[j] = v[j] - mean; s2 += (v[j].x * v[j].x + v[j].y * v[j].y) + (v[j].z * v[j].z + v[j].w * v[j].w); }
            const float rstd = 1.f / sqrtf(wave_sum(s2) * (1.f / DM) + 1e-5f);
            const int b = row / SEQ;
#pragma unroll
            for (int j = 0; j < 4; ++j) { const f32x4 c = *((const f32x4*)(msc + b * 6144) + lane + 64 * j), h = *((const f32x4*)(msh + b * 6144) + lane + 64 * j);
                const f32x4 w = v[j] * rstd * (c + 1.f) + h;
                u32x2 o; o.x = pk2(w.x, w.y); o.y = pk2(w.z, w.w);
                *((u32x2*)(Hout + (size_t)row * DM) + lane + 64 * j) = o; }
        }
    }
}

__device__ __forceinline__ void latent_pass(const Params& p, int l, bf16_t* Z, bf16_t* Hb) {
    const int lane = threadIdx.x & 63, gw = blockIdx.x * 8 + (threadIdx.x >> 6), ngw = gridDim.x * 8;
    const float* qg = p.in[I_QNG] + l * 256; const float* kg = p.in[I_KVNG] + l * 128;
    const float* rc = (const float*)(p.ws + WS_ROPE); const float* rs = rc + SEQ * 16;
    for (int row = gw; row < T; row += ngw) {
        bf16_t* z = Z + (size_t)row * ZP;
        const u32x2 qa = *(const u32x2*)(z + ZC_QLAT + 4 * lane);
        float q0 = bflo(qa.x), q1 = bfhi(qa.x), q2 = bflo(qa.y), q3 = bfhi(qa.y);
        const float qr = 1.f / sqrtf(wave_sum(q0 * q0 + q1 * q1 + q2 * q2 + q3 * q3) * (1.f / 256.f) + 1e-6f);
        const f32x4 g4 = *(const f32x4*)(qg + 4 * lane);
        const unsigned ka = *(const unsigned*)(z + ZC_KVLAT + 2 * lane);
        float k0 = bflo(ka), k1 = bfhi(ka);
        const float kr = 1.f / sqrtf(wave_sum(k0 * k0 + k1 * k1) * (1.f / 128.f) + 1e-6f);
        const float kg0 = kg[2 * lane], kg1 = kg[2 * lane + 1];
        float x1 = 0.f, x2 = 0.f;
        if (lane < 16) { x1 = bf2f(z[ZC_KROPE + lane]); x2 = bf2f(z[ZC_KROPE + 16 + lane]); }
        u32x2 qo; qo.x = pk2(q0 * qr * g4.x, q1 * qr * g4.y); qo.y = pk2(q2 * qr * g4.z, q3 * qr * g4.w);
        *(u32x2*)(z + ZC_QLAT + 4 * lane) = qo;
        *(unsigned*)(z + ZC_KVLAT + 2 * lane) = pk2(k0 * kr * kg0, k1 * kr * kg1);
        if (lane < 16) { const int pos = row & (SEQ - 1); const float c = rc[pos * 16 + lane], s = rs[pos * 16 + lane];
            *(unsigned*)(Hb + (size_t)row * 1024 + 768 + 2 * lane) = pk2(x1 * c - x2 * s, x2 * c + x1 * s); }
    }
}

__device__ __forceinline__ void gmlp_mfma_unit(const Params& p, int l, bf16_t* Z, LAS unsigned char* lds, int nb) {
    const int tid = threadIdx.x, lane = tid & 63, wave = __builtin_amdgcn_readfirstlane(tid >> 6), l15 = lane & 15, lq = lane >> 4;
    LAS bf16_t* vnT = (LAS bf16_t*)lds;
    LAS float* st = (LAS float*)(lds + 34816);
    const int row0 = nb * 128;
    for (int i = 0; i < 16; ++i) { const int tok = wave * 16 + i;
        const u32x4 raw = *(const u32x4*)(Z + (size_t)(row0 + tok) * ZP + ZC_V + lane * 8);
        const float x[8] = {bflo(raw.x), bfhi(raw.x), bflo(raw.y), bfhi(raw.y), bflo(raw.z), bfhi(raw.z), bflo(raw.w), bfhi(raw.w)};
        float s = 0.f;
#pragma unroll
        for (int e = 0; e < 8; ++e) s += x[e];
        const float mean = wave_sum(s) * (1.f / 512.f); float s2 = 0.f;
#pragma unroll
        for (int e = 0; e < 8; ++e) { const float d = x[e] - mean; s2 += d * d; }
        const float rstd = 1.f / sqrtf(wave_sum(s2) * (1.f / 512.f) + 1e-5f);
        if (lane == 0) { st[tok] = mean; st[128 + tok] = rstd; } }
    __syncthreads();
    const int nks = wave < 4 ? 2 : 4, irow = 16 * wave + l15;
    for (int g = 0; g < 4; ++g) {
        const float* lng = p.in[I_GMLNG] + l * 512 + g * 128; const float* lnb = p.in[I_GMLNB] + l * 512 + g * 128;
#pragma unroll
        for (int j = 0; j < 4; ++j) { const int idx = tid + NTHREADS * j, tok = idx >> 4, c8 = (idx & 15) * 8;
            const u32x4 raw = *(const u32x4*)(Z + (size_t)(row0 + tok) * ZP + ZC_V + g * 128 + c8);
            const float x[8] = {bflo(raw.x), bfhi(raw.x), bflo(raw.y), bfhi(raw.y), bflo(raw.z), bfhi(raw.z), bflo(raw.w), bfhi(raw.w)};
            const float mean = st[tok], rstd = st[128 + tok];
#pragma unroll
            for (int e = 0; e < 8; ++e) vnT[(c8 + e) * 136 + tok] = (bf16_t)f2bf((x[e] - mean) * rstd * lng[c8 + e] + lnb[c8 + e]); }
        __syncthreads();
        bf16x8 wf[4];
        const bf16_t* wp = (const bf16_t*)(p.ws + WS_GMW) + ((size_t)(l * 4 + g) * 128 + irow) * 128 + 8 * lq;
#pragma unroll
        for (int ks = 0; ks < 4; ++ks) wf[ks] = (ks < nks) ? *(const bf16x8*)(wp + ks * 32) : (bf16x8){0, 0, 0, 0, 0, 0, 0, 0};
        const float bsv = p.in[I_GMBS][(l * 4 + g) * 128 + irow];
        bf16_t* up = Z + (size_t)(row0 + irow) * ZP + g * 128 + 4 * lq;
#pragma unroll 2
        for (int mt = 0; mt < 8; ++mt) {
            f32x4 acc = (f32x4){0.f, 0.f, 0.f, 0.f};
            const LAS bf16_t* ap = vnT + (mt * 16 + l15) * 136 + 8 * lq;
            acc = __builtin_amdgcn_mfma_f32_16x16x32_bf16(*(const LAS bf16x8*)(ap), wf[0], acc, 0, 0, 0);
            acc = __builtin_amdgcn_mfma_f32_16x16x32_bf16(*(const LAS bf16x8*)(ap + 32), wf[1], acc, 0, 0, 0);
            if (nks == 4) { acc = __builtin_amdgcn_mfma_f32_16x16x32_bf16(*(const LAS bf16x8*)(ap + 64), wf[2], acc, 0, 0, 0);
                            acc = __builtin_amdgcn_mfma_f32_16x16x32_bf16(*(const LAS bf16x8*)(ap + 96), wf[3], acc, 0, 0, 0); }
            const u32x2 uu = *(const u32x2*)(up + mt * 16);
            u32x2 o; o.x = pk2(bflo(uu.x) * (acc[0] + bsv), bfhi(uu.x) * (acc[1] + bsv)); o.y = pk2(bflo(uu.y) * (acc[2] + bsv), bfhi(uu.y) * (acc[3] + bsv));
            *(u32x2*)(up + mt * 16) = o; }
        __syncthreads();
    }
}

__device__ __forceinline__ void lru_wave_unit(const Params& p, int l, bf16_t* Z, LAS unsigned char* ldsw, int b, int ch, int n, int final) {
    const int lane = threadIdx.x & 63, l15 = lane & 15, lq = lane >> 4;
    LAS bf16_t* xcb = (LAS bf16_t*)ldsw;
    LAS float* ab = (LAS float*)(ldsw + 9216);
    float* Ps = (float*)(p.ws + WS_LRUS); float* Hs = Ps + 4 * 128 * 512;
    const size_t rowb = (size_t)b * SEQ; const int t0 = ch * 64, chn0 = n * 64;
    {
        const int c8 = (lane & 7) * 8, tr = lane >> 3, chn = chn0 + c8;
        float cw[4][8], cb[8];
#pragma unroll
        for (int e = 0; e < 8; ++e) { cb[e] = p.in[I_CONVB][l * 512 + chn + e];
#pragma unroll
            for (int k = 0; k < 4; ++k) cw[k][e] = p.in[I_CONVW][(l * 4 + k) * 512 + chn + e]; }
#pragma unroll 2
        for (int i = 0; i < 8; ++i) { const int t = tr + 8 * i; float acc[8];
#pragma unroll
            for (int e = 0; e < 8; ++e) acc[e] = cb[e];
#pragma unroll
            for (int k = 0; k < 4; ++k) { const int tt = t0 + t - 3 + k;
                if (tt >= 0) { const u32x4 raw = *(const u32x4*)(Z + (rowb + tt) * ZP + ZC_LRUX + chn);
                    const float x[8] = {bflo(raw.x), bfhi(raw.x), bflo(raw.y), bfhi(raw.y), bflo(raw.z), bfhi(raw.z), bflo(raw.w), bfhi(raw.w)};
#pragma unroll
                    for (int e = 0; e < 8; ++e) acc[e] += x[e] * cw[k][e]; } }
            u32x4 o; o.x = pk2(acc[0], acc[1]); o.y = pk2(acc[2], acc[3]); o.z = pk2(acc[4], acc[5]); o.w = pk2(acc[6], acc[7]);
            *(LAS u32x4*)(xcb + t * 72 + c8) = o; }
    }
    bf16x8 wrf[4][2], wif[4][2]; float sp4[4], br4[4], bi4[4];
    { const bf16_t* wT = (const bf16_t*)(p.ws + WS_LRUW) + ((size_t)(l * 8 + n) * 64) * 64;
#pragma unroll
        for (int nt = 0; nt < 4; ++nt) { const int d = nt * 16 + l15;
#pragma unroll
            for (int k = 0; k < 2; ++k) { wrf[nt][k] = *(const bf16x8*)(wT + d * 64 + k * 32 + 8 * lq); wif[nt][k] = *(const bf16x8*)(wT + 65536 + d * 64 + k * 32 + 8 * lq); }
            sp4[nt] = -8.f * 1.4426950408889634f * log1pf(__expf(-p.in[I_LAM][l * 512 + chn0 + d]));     br4[nt] = p.in[I_BR][l * 512 + chn0 + d]; bi4[nt] = p.in[I_BI][l * 512 + chn0 + d]; } }
    const size_t sbase = (size_t)b * 128 * 512 + chn0 + lane;
    float h = 0.f, P = 1.f;
    if (final) {
        int k = 0;
        for (; k + 32 <= ch; k += 32) { float pp[32], hh[32];
#pragma unroll
            for (int e = 0; e < 32; ++e) { pp[e] = Ps[sbase + (size_t)(k + e) * 512]; hh[e] = Hs[sbase + (size_t)(k + e) * 512]; }
#pragma unroll
            for (int e = 0; e < 32; ++e) h = pp[e] * h + hh[e]; }
        for (; k + 8 <= ch; k += 8) { float pp[8], hh[8];
#pragma unroll
            for (int e = 0; e < 8; ++e) { pp[e] = Ps[sbase + (size_t)(k + e) * 512]; hh[e] = Hs[sbase + (size_t)(k + e) * 512]; }
#pragma unroll
            for (int e = 0; e < 8; ++e) h = pp[e] * h + hh[e]; }
        for (; k < ch; ++k) h = Ps[sbase + (size_t)k * 512] * h + Hs[sbase + (size_t)k * 512];
    }
    bf16_t* gp = Z + (rowb + t0) * ZP + ZC_LRUG + chn0 + lane;
#pragma unroll 1
    for (int mt = 0; mt < 4; ++mt) {
        const bf16x8 a0 = *(const LAS bf16x8*)(xcb + (mt * 16 + l15) * 72 + 8 * lq), a1 = *(const LAS bf16x8*)(xcb + (mt * 16 + l15) * 72 + 32 + 8 * lq);
#pragma unroll
        for (int nt = 0; nt < 4; ++nt) {
            f32x4 ar = (f32x4){0.f, 0.f, 0.f, 0.f}, ai = (f32x4){0.f, 0.f, 0.f, 0.f};
            ar = __builtin_amdgcn_mfma_f32_16x16x32_bf16(a0, wrf[nt][0], ar, 0, 0, 0); ar = __builtin_amdgcn_mfma_f32_16x16x32_bf16(a1, wrf[nt][1], ar, 0, 0, 0);
            ai = __builtin_amdgcn_mfma_f32_16x16x32_bf16(a0, wif[nt][0], ai, 0, 0, 0); ai = __builtin_amdgcn_mfma_f32_16x16x32_bf16(a1, wif[nt][1], ai, 0, 0, 0);
            const int d = nt * 16 + l15;
#pragma unroll
            for (int j = 0; j < 4; ++j) { const int tl = 4 * lq + j;
                const float er = 1.f + __builtin_amdgcn_exp2f(fminf(-1.4426950408889634f * (ar[j] + br4[nt]), 60.f)), ei = 1.f + __builtin_amdgcn_exp2f(fminf(-1.4426950408889634f * (ai[j] + bi4[nt]), 60.f));
                const float rc2 = __builtin_amdgcn_rcpf(er * ei), r = rc2 * ei, ig = rc2 * er;
                const float a = __builtin_amdgcn_exp2f(r * sp4[nt]);
                const float xcv = bf2f(xcb[(mt * 16 + tl) * 72 + d]);
                ab[tl * 64 + d] = a; ab[1024 + tl * 64 + d] = __builtin_amdgcn_sqrtf(fmaxf(1.f - a * a, 0.f)) * (ig * xcv); }
        }
        if (final) {
            unsigned g16[16];
#pragma unroll
            for (int tt = 0; tt < 16; ++tt) g16[tt] = gp[(size_t)(mt * 16 + tt) * ZP];
#pragma unroll
            for (int tt = 0; tt < 16; ++tt) { h = ab[tt * 64 + lane] * h + ab[1024 + tt * 64 + lane]; gp[(size_t)(mt * 16 + tt) * ZP] = (bf16_t)f2bf(h * bf2f(g16[tt])); }
        } else {
#pragma unroll
            for (int tt = 0; tt < 16; ++tt) { const float a = ab[tt * 64 + lane]; h = a * h + ab[1024 + tt * 64 + lane]; P *= a; }
        }
    }
    if (!final) { Ps[sbase + (size_t)ch * 512] = P; Hs[sbase + (size_t)ch * 512] = h; }
}

typedef float f32x16 __attribute__((ext_vector_type(16)));
typedef short s16x4 __attribute__((ext_vector_type(4)));
constexpr int AT_KROW = 208, AT_VOFF = 64 * AT_KROW, AT_STAGE = AT_VOFF + 8192;
constexpr int A2_VOFF = 128 * AT_KROW, A2_STAGE = A2_VOFF + 16384;
typedef __bf16 bf16x2_n __attribute__((ext_vector_type(2)));
__device__ __forceinline__ unsigned cvtpk2(float lo, float hi) { const f32x2 v = {lo, hi}; const bf16x2_n b = __builtin_convertvector(v, bf16x2_n); return __builtin_bit_cast(unsigned, b); }
__device__ __forceinline__ void a2_qk(const LAS unsigned char* kb, const bf16x8 (&qf)[6], const f32x16& cneg, f32x16& st0, f32x16& st1) {
    { const bf16x8 a0 = *(const LAS bf16x8*)(kb), a1 = *(const LAS bf16x8*)(kb + 32 * AT_KROW);
      st0 = __builtin_amdgcn_mfma_f32_32x32x16_bf16(a0, qf[0], cneg, 0, 0, 0); st1 = __builtin_amdgcn_mfma_f32_32x32x16_bf16(a1, qf[0], cneg, 0, 0, 0); }
#pragma unroll
    for (int s = 1; s < 6; ++s) { const bf16x8 a0 = *(const LAS bf16x8*)(kb + s * 32), a1 = *(const LAS bf16x8*)(kb + 32 * AT_KROW + s * 32);
        st0 = __builtin_amdgcn_mfma_f32_32x32x16_bf16(a0, qf[s], st0, 0, 0, 0); st1 = __builtin_amdgcn_mfma_f32_32x32x16_bf16(a1, qf[s], st1, 0, 0, 0); }
}
__device__ __forceinline__ bool a2_softmax(f32x16& st0, f32x16& st1, f32x16& ot0, f32x16& ot1, f32x16& cneg, float& mrun, float& lsum, bool first, bf16x8 (&pf)[4]) {
    float mt = fmaxf(st0[0], st1[0]);
#pragma unroll
    for (int r = 1; r < 16; ++r) mt = fmaxf(fmaxf(mt, st0[r]), st1[r]);
    mt = fmaxf(mt, __shfl_xor(mt, 32));
    const bool refresh = first || __builtin_amdgcn_ballot_w64(mt > 8.f) != 0ull;
    if (refresh) {
        const float delta = first ? mt : fmaxf(mt, 0.f), alpha = first ? 0.f : __builtin_amdgcn_exp2f(-delta);
        mrun += delta; lsum *= alpha;
#pragma unroll
        for (int r = 0; r < 16; ++r) { ot0[r] *= alpha; ot1[r] *= alpha; st0[r] -= delta; st1[r] -= delta; cneg[r] = -mrun; }
    }
    float ps = 0.f;
#pragma unroll
    for (int r = 0; r < 16; ++r) { st0[r] = __builtin_amdgcn_exp2f(st0[r]); st1[r] = __builtin_amdgcn_exp2f(st1[r]); ps += st0[r] + st1[r]; }
    lsum += ps;
    u32x4 w;
    w.x = cvtpk2(st0[0], st0[1]); w.y = cvtpk2(st0[2], st0[3]); w.z = cvtpk2(st0[4], st0[5]); w.w = cvtpk2(st0[6], st0[7]); pf[0] = __builtin_bit_cast(bf16x8, w);
    w.x = cvtpk2(st0[8], st0[9]); w.y = cvtpk2(st0[10], st0[11]); w.z = cvtpk2(st0[12], st0[13]); w.w = cvtpk2(st0[14], st0[15]); pf[1] = __builtin_bit_cast(bf16x8, w);
    w.x = cvtpk2(st1[0], st1[1]); w.y = cvtpk2(st1[2], st1[3]); w.z = cvtpk2(st1[4], st1[5]); w.w = cvtpk2(st1[6], st1[7]); pf[2] = __builtin_bit_cast(bf16x8, w);
    w.x = cvtpk2(st1[8], st1[9]); w.y = cvtpk2(st1[10], st1[11]); w.z = cvtpk2(st1[12], st1[13]); w.w = cvtpk2(st1[14], st1[15]); pf[3] = __builtin_bit_cast(bf16x8, w);
    return refresh;
}
__device__ __forceinline__ float a2_max(const f32x16& st0, const f32x16& st1) {
    float mt = fmaxf(st0[0], st1[0]);
#pragma unroll
    for (int r = 1; r < 16; ++r) mt = fmaxf(fmaxf(mt, st0[r]), st1[r]);
    return fmaxf(mt, __shfl_xor(mt, 32));
}
__device__ __forceinline__ void a2_exp_pack(f32x16& st0, f32x16& st1, float& lsum, bf16x8 (&pf)[4]) {
    float ps = 0.f;
#pragma unroll
    for (int r = 0; r < 16; ++r) { st0[r] = __builtin_amdgcn_exp2f(st0[r]); st1[r] = __builtin_amdgcn_exp2f(st1[r]); ps += st0[r] + st1[r]; }
    lsum += ps;
    u32x4 w;
    w.x = cvtpk2(st0[0], st0[1]); w.y = cvtpk2(st0[2], st0[3]); w.z = cvtpk2(st0[4], st0[5]); w.w = cvtpk2(st0[6], st0[7]); pf[0] = __builtin_bit_cast(bf16x8, w);
    w.x = cvtpk2(st0[8], st0[9]); w.y = cvtpk2(st0[10], st0[11]); w.z = cvtpk2(st0[12], st0[13]); w.w = cvtpk2(st0[14], st0[15]); pf[1] = __builtin_bit_cast(bf16x8, w);
    w.x = cvtpk2(st1[0], st1[1]); w.y = cvtpk2(st1[2], st1[3]); w.z = cvtpk2(st1[4], st1[5]); w.w = cvtpk2(st1[6], st1[7]); pf[2] = __builtin_bit_cast(bf16x8, w);
    w.x = cvtpk2(st1[8], st1[9]); w.y = cvtpk2(st1[10], st1[11]); w.z = cvtpk2(st1[12], st1[13]); w.w = cvtpk2(st1[14], st1[15]); pf[3] = __builtin_bit_cast(bf16x8, w);
}
__device__ __forceinline__ void a2_pv(const LAS unsigned char* vb, const bf16x8 (&pf)[4], f32x16& ot0, f32x16& ot1) {
#pragma unroll
    for (int s = 0; s < 4; ++s) {
        const s16x4 a00 = __builtin_bit_cast(s16x4, __builtin_amdgcn_ds_read_tr16_b64_v4i16((LAS s16x4*)(vb + (16 * s) * 64)));
        const s16x4 a01 = __builtin_bit_cast(s16x4, __builtin_amdgcn_ds_read_tr16_b64_v4i16((LAS s16x4*)(vb + (16 * s + 8) * 64)));
        const s16x4 a10 = __builtin_bit_cast(s16x4, __builtin_amdgcn_ds_read_tr16_b64_v4i16((LAS s16x4*)(vb + 8192 + (16 * s) * 64)));
        const s16x4 a11 = __builtin_bit_cast(s16x4, __builtin_amdgcn_ds_read_tr16_b64_v4i16((LAS s16x4*)(vb + 8192 + (16 * s + 8) * 64)));
        const bf16x8 va0 = (bf16x8){a00[0], a00[1], a00[2], a00[3], a01[0], a01[1], a01[2], a01[3]};
        const bf16x8 va1 = (bf16x8){a10[0], a10[1], a10[2], a10[3], a11[0], a11[1], a11[2], a11[3]};
        ot0 = __builtin_amdgcn_mfma_f32_32x32x16_bf16(va0, pf[s], ot0, 0, 0, 0); ot1 = __builtin_amdgcn_mfma_f32_32x32x16_bf16(va1, pf[s], ot1, 0, 0, 0); }
}
__device__ __forceinline__ void attn2_unit(bf16_t* Z, const bf16_t* Hb, const float* rc, const float* rs, LAS unsigned char* lds, int b, int h, int qblk) {
    const int tid = threadIdx.x, lane = tid & 63, wave = __builtin_amdgcn_readfirstlane(tid >> 6);
    const int l31 = lane & 31, hi = lane >> 5, l15 = lane & 15;
    const size_t rowb = (size_t)b * SEQ;
    const int q0 = qblk * 256 + wave * 32, cw = q0 >> 6, npairs = qblk * 2 + 2;
    const bf16_t* ksrc[4]; unsigned kstp[4]; const bf16_t* vsrc[2];
#pragma unroll
    for (int j = 0; j < 4; ++j) { const int pidx = (wave + 8 * j) * 64 + lane, key = (pidx / 13) & 127, c = pidx % 13, cc = c < 12 ? c : 0;
        ksrc[j] = cc < 8 ? Z + (rowb + key) * ZP + ZC_KN + h * 64 + cc * 8 : Hb + (rowb + key) * 1024 + 768 + (cc - 8) * 8;
        kstp[j] = cc < 8 ? 128u * ZP : 128u * 1024u; }
#pragma unroll
    for (int j = 0; j < 2; ++j) { const int pidx = (wave + 8 * j) * 64 + lane, dt = pidx >> 9, key = (pidx >> 2) & 127, cc = pidx & 3;
        vsrc[j] = Z + (rowb + key) * ZP + ZC_V + h * 64 + dt * 32 + cc * 8; }
    const int nkb = wave < 2 ? 4 : 3;
#define A2_STAGE_LOAD(stage_off, kpair) do { \
        _Pragma("unroll") for (int j = 0; j < 4; ++j) if (j < nkb) __builtin_amdgcn_global_load_lds((const unsigned*)(ksrc[j] + (size_t)(kpair) * kstp[j]), (LAS unsigned*)(lds + (stage_off) + (wave + 8 * j) * 1024), 16, 0, 0); \
        _Pragma("unroll") for (int j = 0; j < 2; ++j) __builtin_amdgcn_global_load_lds((const unsigned*)(vsrc[j] + (size_t)(kpair) * 128 * ZP), (LAS unsigned*)(lds + (stage_off) + A2_VOFF + (wave + 8 * j) * 1024), 16, 0, 0); } while (0)
    __syncthreads();
    A2_STAGE_LOAD(0, 0);
    bf16x8 qf[6];
    { const bf16_t* qp = Hb + (rowb + q0 + l31) * 1024 + h * 96 + 8 * hi;
#pragma unroll
        for (int s = 0; s < 6; ++s) qf[s] = *(const bf16x8*)(qp + 16 * s);
        const int pos = q0 + l31;
#pragma unroll
        for (int s = 4; s < 6; ++s) { const u32x4 raw = __builtin_bit_cast(u32x4, qf[s]); const int i0 = 8 * (s - 4) + 4 * hi;
            const f32x4 c = *(const f32x4*)(rc + pos * 16 + i0), sn = *(const f32x4*)(rs + pos * 16 + i0);
            u32x4 o;
            { const float x1 = bflo(raw.x), x2 = bfhi(raw.x); o.x = cvtpk2(x1 * c[0] - x2 * sn[0], x2 * c[0] + x1 * sn[0]); }
            { const float x1 = bflo(raw.y), x2 = bfhi(raw.y); o.y = cvtpk2(x1 * c[1] - x2 * sn[1], x2 * c[1] + x1 * sn[1]); }
            { const float x1 = bflo(raw.z), x2 = bfhi(raw.z); o.z = cvtpk2(x1 * c[2] - x2 * sn[2], x2 * c[2] + x1 * sn[2]); }
            { const float x1 = bflo(raw.w), x2 = bfhi(raw.w); o.w = cvtpk2(x1 * c[3] - x2 * sn[3], x2 * c[3] + x1 * sn[3]); }
            qf[s] = __builtin_bit_cast(bf16x8, o); } }
    __syncthreads();
    f32x16 ot0, ot1, cneg;
#pragma unroll
    for (int r = 0; r < 16; ++r) { ot0[r] = 0.f; ot1[r] = 0.f; cneg[r] = 0.f; }
    float mrun = 0.f, lsum = 0.f;
    const int kboff = l31 * AT_KROW + hi * 16;
    const int vboff = A2_VOFF + (4 * hi + (l15 >> 2)) * 64 + (16 * ((lane >> 4) & 1) + 4 * (l15 & 3)) * 2;
    for (int kp = 0; kp < npairs; ++kp) {
        const int sb = (kp & 1) * A2_STAGE, sbn = A2_STAGE - sb;
        const bool more = kp + 1 < npairs;
        if (more) A2_STAGE_LOAD(sbn, kp + 1);
        const LAS unsigned char* kb = lds + sb + kboff; const LAS unsigned char* vb = lds + sb + vboff;
        if (2 * kp + 1 <= cw) {
            f32x16 sa0, sa1, sb0, sb1; bf16x8 pa[4], pb[4];
            __builtin_amdgcn_s_setprio(1);
            a2_qk(kb, qf, cneg, sa0, sa1);
            a2_qk(kb + 64 * AT_KROW, qf, cneg, sb0, sb1);
            __builtin_amdgcn_s_setprio(0);
            const float mt = fmaxf(a2_max(sa0, sa1), a2_max(sb0, sb1));
            if (kp == 0 || __builtin_amdgcn_ballot_w64(mt > 8.f) != 0ull) {
                const float delta = (kp == 0) ? mt : fmaxf(mt, 0.f), alpha = (kp == 0) ? 0.f : __builtin_amdgcn_exp2f(-delta);
                mrun += delta; lsum *= alpha;
#pragma unroll
                for (int r = 0; r < 16; ++r) { ot0[r] *= alpha; ot1[r] *= alpha; sa0[r] -= delta; sa1[r] -= delta; sb0[r] -= delta; sb1[r] -= delta; cneg[r] = -mrun; }
            }
            a2_exp_pack(sa0, sa1, lsum, pa);
            a2_pv(vb, pa, ot0, ot1);
            a2_exp_pack(sb0, sb1, lsum, pb);
            a2_pv(vb + 64 * 64, pb, ot0, ot1);
        } else if (2 * kp <= cw) {
            f32x16 sa0, sa1; bf16x8 pa[4];
            a2_qk(kb, qf, cneg, sa0, sa1);
            const float mt = a2_max(sa0, sa1);
            if (kp == 0 || __builtin_amdgcn_ballot_w64(mt > 8.f) != 0ull) {
                const float delta = (kp == 0) ? mt : fmaxf(mt, 0.f), alpha = (kp == 0) ? 0.f : __builtin_amdgcn_exp2f(-delta);
                mrun += delta; lsum *= alpha;
#pragma unroll
                for (int r = 0; r < 16; ++r) { ot0[r] *= alpha; ot1[r] *= alpha; sa0[r] -= delta; sa1[r] -= delta; cneg[r] = -mrun; }
            }
            a2_exp_pack(sa0, sa1, lsum, pa);
            a2_pv(vb, pa, ot0, ot1);
        }
        __syncthreads();
    }
    lsum += __shfl_xor(lsum, 32);
    const float inv = 1.f / lsum;
    bf16_t* op = Z + (rowb + q0 + l31) * ZP + ZC_YB + h * 64 + 4 * hi;
#pragma unroll
    for (int g4 = 0; g4 < 4; ++g4) {
        u32x2 w0; w0.x = cvtpk2(ot0[4 * g4] * inv, ot0[4 * g4 + 1] * inv); w0.y = cvtpk2(ot0[4 * g4 + 2] * inv, ot0[4 * g4 + 3] * inv); *(u32x2*)(op + 8 * g4) = w0;
        u32x2 w1; w1.x = cvtpk2(ot1[4 * g4] * inv, ot1[4 * g4 + 1] * inv); w1.y = cvtpk2(ot1[4 * g4 + 2] * inv, ot1[4 * g4 + 3] * inv); *(u32x2*)(op + 32 + 8 * g4) = w1; }
}

#ifndef PHMASK
#define PHMASK 0xFFFF
#endif
#define PHON(k) ((PHMASK >> (k)) & 1)
constexpr int NPHASE = 24;
template <int ph>
__device__ __forceinline__ void run_phase(const Params& p, unsigned char* lds, const int vc, const LnRows lnl) {
    unsigned char* ws = p.ws;
    const int G = gridDim.x, bx = vc;
    const LnRows lng{(int)blockIdx.x * 8 + (int)(threadIdx.x >> 6), (int)gridDim.x * 8, 0, T};
    bf16_t* Hb = (bf16_t*)(ws + WS_H); bf16_t* Z = (bf16_t*)(ws + WS_Z);
    float* X = p.out;
    const float* mod = (const float*)(ws + WS_MOD);
    LAS unsigned char* ldsl = (LAS unsigned char*)lds;
    {
        if (ph == 0) { if (PHON(12)) prologue<0>(p, lds); }
        else if (ph == NPHASE - 1) { if (PHON(0)) ln_pass(X, X, p.in[I_LNG] + (1 * 2 + 1) * DM, p.in[I_LNB] + (1 * 2 + 1) * DM, nullptr, nullptr, nullptr, nullptr, lnl); }
        else {
            const int l = (ph - 1) / 11, sp = (ph - 1) % 11;
            const float* modl = mod + l * 4 * 6144;
            if (sp == 0 && PHON(0)) {
                if (l == 0) { prologue<1>(p, lds); ln_pass(p.in[I_X], nullptr, nullptr, nullptr, modl + 1 * 1024, modl + 0 * 1024, Hb, nullptr, lng); }
                else ln_pass(X, nullptr, p.in[I_LNG] + (0 * 2 + 1) * DM, p.in[I_LNB] + (0 * 2 + 1) * DM, modl + 1 * 1024, modl + 0 * 1024, Hb, (float*)(ws + WS_STAT) + 2 * T, lnl);
            } else if (sp == 1 && PHON(1)) {
                pg8::Gemm g{Hb, (const bf16_t*)(ws + WS_WIN) + (size_t)l * ZP * 1024, 1024, 1024}; pg8::StaticOrder S; S.init(T, ZP, G, bx);
                pg8::EpiZ E{Z, (const float*)(ws + WS_BIASP) + l * ZP};
                pg8::gemm_phase<pg8::EpiZ, pg8::StaticOrder>(ldsl, g, S, E);
            } else if (sp == 2 && PHON(2)) {
                for (int u = bx; u < 256; u += G) gmlp_mfma_unit(p, l, Z, ldsl, u);
                latent_pass(p, l, Z, Hb);
                __syncthreads();
                if (lnl.ngw == 256) {
                    const int lw = __builtin_amdgcn_readfirstlane(lnl.gw), xx = lnl.rbase >> 12;
                    for (int k = 0; k < 2; ++k) { const int id = lw + 256 * k, combo = 4 * xx + (id >> 7);
                        lru_wave_unit(p, l, Z, ldsl + __builtin_amdgcn_readfirstlane(threadIdx.x >> 6) * 17408, combo >> 3, k ? 127 - (id & 127) : (id & 127), combo & 7, 0); }
                } else
                for (int u = bx * 8 + __builtin_amdgcn_readfirstlane(threadIdx.x >> 6); u < 4096; u += G * 8) lru_wave_unit(p, l, Z, ldsl + __builtin_amdgcn_readfirstlane(threadIdx.x >> 6) * 17408, u >> 10, (u >> 3) & 127, u & 7, 0);
            } else if (sp == 3 && PHON(3)) {
                if (lnl.ngw == 256) {
                    const int lw = __builtin_amdgcn_readfirstlane(lnl.gw), xx = lnl.rbase >> 12;
                    for (int k = 0; k < 2; ++k) { const int id = lw + 256 * k, combo = 4 * xx + (id >> 7);
                        lru_wave_unit(p, l, Z, ldsl + __builtin_amdgcn_readfirstlane(threadIdx.x >> 6) * 17408, combo >> 3, k ? 127 - (id & 127) : (id & 127), combo & 7, 1); }
                } else
                for (int u = bx * 8 + __builtin_amdgcn_readfirstlane(threadIdx.x >> 6); u < 4096; u += G * 8) lru_wave_unit(p, l, Z, ldsl + __builtin_amdgcn_readfirstlane(threadIdx.x >> 6) * 17408, u >> 10, (u >> 3) & 127, u & 7, 1);
            } else if (sp == 4 && PHON(4)) {
                pg8::Gemm g{Z + ZC_QLAT, (const bf16_t*)(ws + WS_WUP) + (size_t)l * NUP * KUP, ZP, KUP}; pg8::StaticOrder S; S.init(T, NUP, G, bx);
                pg8::EpiUp E{Hb, Z};
                pg8::gemm_phase<pg8::EpiUp, pg8::StaticOrder>(ldsl, g, S, E);
            } else if (sp == 5 && PHON(5)) {
                const float* rc = (const float*)(ws + WS_ROPE); const float* rs = rc + SEQ * 16;
                if (G == 256) {
                    const int x = bx & 7, j = bx >> 3;
                    for (int r = 0; r < 2; ++r) { const int bh = 4 * x + 2 * r + (j >> 4), pp = j & 15;
                        attn2_unit(Z, Hb, rc, rs, ldsl, bh >> 3, bh & 7, 31 - pp);
                        attn2_unit(Z, Hb, rc, rs, ldsl, bh >> 3, bh & 7, pp); }
                } else {
                    for (int w = bx; w < 512; w += G) { const int bh = w >> 4, pp = w & 15;
                        attn2_unit(Z, Hb, rc, rs, ldsl, bh >> 3, bh & 7, 31 - pp);
                        attn2_unit(Z, Hb, rc, rs, ldsl, bh >> 3, bh & 7, pp); }
                }
            } else if (sp == 6 && PHON(6)) {
                pg8::Gemm g{Z, (const bf16_t*)(ws + WS_WBR) + (size_t)l * 3072 * 512, ZP, 512}; pg8::BranchOrder S{G, bx};
                pg8::EpiBranch E{Hb, Z};
                pg8::gemm_phase<pg8::EpiBranch, pg8::BranchOrder>(ldsl, g, S, E);
            } else if (sp == 7 && PHON(7)) {
                pg8::Gemm g{Hb, (const bf16_t*)(ws + WS_WMIX) + (size_t)l * 1024 * 1024, 1024, 1024}; pg8::StaticOrder S; S.init(T, DM, G, bx);
                pg8::EpiRes E{l == 0 ? p.in[I_X] : X, X, modl + 2 * 1024, nullptr, l == 0 ? nullptr : (const float*)(ws + WS_STAT) + 2 * T, p.in[I_LNG] + (0 * 2 + 1) * DM, p.in[I_LNB] + (0 * 2 + 1) * DM};
                pg8::gemm_phase<pg8::EpiRes, pg8::StaticOrder>(ldsl, g, S, E);
            } else if (sp == 8 && PHON(8)) {
                ln_pass(X, nullptr, p.in[I_LNG] + (l * 2 + 0) * DM, p.in[I_LNB] + (l * 2 + 0) * DM, modl + 4 * 1024, modl + 3 * 1024, Hb, (float*)(ws + WS_STAT), lnl);
            } else if (sp == 9 && PHON(9)) {
                pg8::Gemm g{Hb, (const bf16_t*)(ws + WS_W1) + (size_t)l * FF * 1024, 1024, 1024}; pg8::StaticOrder S; S.init(T, FF, G, bx);
                pg8::EpiFF1 E{Z, p.in[I_B1] + l * FF};
                pg8::gemm_phase<pg8::EpiFF1, pg8::StaticOrder>(ldsl, g, S, E);
            } else if (PHON(10)) {
                pg8::Gemm g{Z, (const bf16_t*)(ws + WS_W2) + (size_t)l * 1024 * FF, ZP, FF}; pg8::StaticOrder S; S.init(T, DM, G, bx);
                pg8::EpiRes E{X, X, modl + 5 * 1024, p.in[I_B2] + l * DM, (const float*)(ws + WS_STAT), p.in[I_LNG] + (l * 2 + 0) * DM, p.in[I_LNB] + (l * 2 + 0) * DM};
                pg8::gemm_phase<pg8::EpiRes, pg8::StaticOrder>(ldsl, g, S, E);
            }
        }
    }
}
__global__ void __launch_bounds__(NTHREADS, 2) fwd_kernel(Params p) {
    extern __shared__ __attribute__((aligned(16))) unsigned char lds[];
    cg::grid_group grid = cg::this_grid();
    volatile LAS unsigned* bst = (volatile LAS unsigned*)((LAS unsigned char*)lds + LDS_BYTES - 16);
    if (threadIdx.x == 0) { bst[0] = 0u; bst[1] = 0u; }
    __syncthreads();
    volatile LAS unsigned* bst2 = (volatile LAS unsigned*)((LAS unsigned char*)lds + LDS_BYTES - 32);
    XcdBarrier xbar; xbar.bar = (unsigned*)(p.ws + WS_BAR); xbar.x = xb_xcc_id(); xbar.st = bst;
    if (threadIdx.x == 0) bst2[0] = xb_add(&xbar.bar[XB_XCNT(xbar.x)], 1u);
    __syncthreads();
    const int xrank = (int)bst2[0];
    int vc = blockIdx.x, use_local = 0;
    LnRows lnl{(int)blockIdx.x * 8 + (int)(threadIdx.x >> 6), (int)gridDim.x * 8, 0, T};
#define GSYNC(PH) do { if ((PH) == 0) grid.sync(); else if (use_local && ((PH) == 3 || (PH) == 14 || (PH) == 8 || (PH) == 9 || (PH) == 10 || (PH) == 11 || (PH) == 12 || (PH) == 19 || (PH) == 20 || (PH) == 21 || (PH) == 22)) xcd_local_barrier(xbar); else xcd_barrier(xbar); \
    if ((PH) == 1) { if (threadIdx.x == 0 && !(gridDim.x == 256 && bst[0] == 32u && bst[1] == 8u && xbar.x < 8u && xrank < 32)) xb_add(&xbar.bar[XB_BAD], 1u); } \
    if ((PH) == 2) { if (threadIdx.x == 0) bst2[1] = (xb_ld(&xbar.bar[XB_BAD]) == 0u) ? 1u : 0u; __syncthreads(); use_local = (int)bst2[1]; \
        if (use_local) { vc = xrank * 8 + (int)xbar.x; lnl = LnRows{xrank * 8 + (int)(threadIdx.x >> 6), 256, (int)xbar.x * 4096, (int)xbar.x * 4096 + 4096}; } } } while (0)
#ifndef XSYNC
#define XSYNC 0
#endif
#ifndef REPPH
#define REPPH -1
#endif
#ifndef REPSP
#define REPSP -1
#endif
#define RUN(PH) if (p.ph_lo <= PH && PH < p.ph_hi) { run_phase<PH>(p, lds, vc, lnl); if (PH > 0 && PH < 23 && (PH - 1) % 11 == REPSP) { GSYNC(PH); run_phase<PH>(p, lds, vc, lnl); } if (PH + 1 < p.ph_hi) { GSYNC(PH); if (XSYNC) GSYNC(PH); } if (PH == REPPH) { run_phase<PH>(p, lds, vc, lnl); GSYNC(PH); } }
    RUN(0) RUN(1) RUN(2) RUN(3) RUN(4) RUN(5) RUN(6) RUN(7) RUN(8) RUN(9) RUN(10) RUN(11)
    RUN(12) RUN(13) RUN(14) RUN(15) RUN(16) RUN(17) RUN(18) RUN(19) RUN(20) RUN(21) RUN(22) RUN(23)
#undef RUN
}

extern "C" void kernel_launch(void* const* d_in, const int* in_sizes, int n_in, void* d_out, int out_size, void* d_ws, size_t ws_size, hipStream_t stream) {
    static int grid = 0;
    if (grid == 0) {
        if (n_in != 29 || out_size != T * DM || ws_size < WS_END) { fprintf(stderr, "kernel_launch: unexpected sizes n_in %d out %d ws %zu (need %zu)\n", n_in, out_size, ws_size, (size_t)WS_END); grid = -1; return; }
        int dev = 0, cus = 0, per_cu = 0;
        hipGetDevice(&dev); hipDeviceGetAttribute(&cus, hipDeviceAttributeMultiprocessorCount, dev);
        if (hipFuncSetAttribute((const void*)fwd_kernel, hipFuncAttributeMaxDynamicSharedMemorySize, LDS_BYTES) != hipSuccess) { fprintf(stderr, "kernel_launch: hipFuncSetAttribute failed\n"); grid = -1; return; }
        if (hipOccupancyMaxActiveBlocksPerMultiprocessor(&per_cu, (const void*)fwd_kernel, NTHREADS, LDS_BYTES) != hipSuccess || per_cu < 1) { fprintf(stderr, "kernel_launch: occupancy query says %d\n", per_cu); per_cu = 1; }
        (void)hipGetLastError();
        grid = cus * 1;
        fprintf(stderr, "kernel_launch: grid %d (cus %d, per_cu %d), ws %zu\n", grid, cus, per_cu, ws_size);
    }
    if (grid < 0) return;
    if (hipMemsetAsync((char*)d_ws + WS_BAR, 0, 16384, stream) != hipSuccess) { fprintf(stderr, "kernel_launch: memset failed\n"); return; }
    Params p{};
    for (int i = 0; i < 29; ++i) p.in[i] = (const float*)d_in[i];
    p.out = (float*)d_out; p.ws = (unsigned char*)d_ws; p.ph_lo = 0; p.ph_hi = NPHASE;
    void* args[] = {&p};
    hipError_t e = hipLaunchCooperativeKernel((const void*)fwd_kernel, dim3(grid), dim3(NTHREADS), args, LDS_BYTES, stream);
    if (e != hipSuccess) fprintf(stderr, "kernel_launch: cooperative launch failed: %s (grid %d)\n", hipGetErrorString(e), grid);
}
```

```cpp
#include <hip/hip_runtime.h>
#include <hip/hip_cooperative_groups.h>
#include <cstdio>
#include <cstdint>
namespace cg = cooperative_groups;

#define LAS __attribute__((address_space(3)))
typedef unsigned short bf16_t;
typedef short bf16x8 __attribute__((ext_vector_type(8)));
typedef float f32x4 __attribute__((ext_vector_type(4)));
typedef float f32x2 __attribute__((ext_vector_type(2)));
typedef unsigned u32x4 __attribute__((ext_vector_type(4)));
typedef unsigned u32x2 __attribute__((ext_vector_type(2)));

constexpr int NBATCH = 4, SEQ = 8192, T = NBATCH * SEQ, DM = 1024, NIN = 5536, ZP = 5632, FF = 4096;
constexpr int NUP = 1792, KUP = 384;
constexpr float ALPHA = 1.4142135623730951f;
constexpr float QSCALE = 0.10206207261596575f * 1.4426950408889634f;
constexpr int ZC_V = 512, ZC_QLAT = 1024, ZC_KVLAT = 1280, ZC_KROPE = 1408, ZC_YB = 1024, ZC_LRUX = 1536, ZC_KN = 1536, ZC_LRUG = 2048, ZC_GATE = 2560;
constexpr size_t MiB = 1u << 20;
constexpr size_t WS_MOD = 0, WS_BIASP = 262144, WS_ROPE = 1 * MiB, WS_BAR = 524288, WS_LRUS = 2 * MiB, WS_LRUW = 4 * MiB, WS_GMW = 5 * MiB, WS_STAT = 6 * MiB, WS_WIN = 8 * MiB, WS_WUP = 30 * MiB, WS_WBR = 33 * MiB, WS_WMIX = 39 * MiB,
                 WS_W1 = 43 * MiB, WS_W2 = 59 * MiB, WS_H = 76 * MiB, WS_Z = 140 * MiB, WS_END = 492 * MiB;
constexpr int LDS_BYTES = 147456;
constexpr int NTHREADS = 512;

__device__ __forceinline__ float bf2f(unsigned u) { return __builtin_bit_cast(float, u << 16); }
__device__ __forceinline__ float bflo(unsigned u) { return __builtin_bit_cast(float, u << 16); }
__device__ __forceinline__ float bfhi(unsigned u) { return __builtin_bit_cast(float, u & 0xffff0000u); }
__device__ __forceinline__ unsigned f2bf(float f) { unsigned u = __builtin_bit_cast(unsigned, f); return (u + 0x7fffu + ((u >> 16) & 1u)) >> 16; }
__device__ __forceinline__ unsigned pk2(float lo, float hi) { return f2bf(lo) | (f2bf(hi) << 16); }
__device__ __forceinline__ float sigmoidf_(float x) { return __builtin_amdgcn_rcpf(1.f + __builtin_amdgcn_exp2f(-1.4426950408889634f * x)); }
__device__ __forceinline__ float gelu_t(float x) { const float u = x * (-2.3022081986f - 0.1029432404f * x * x); return x * __builtin_amdgcn_rcpf(1.f + __builtin_amdgcn_exp2f(u)); }
template <int CTRL> __device__ __forceinline__ float dpp_mov(float v) {
    return __builtin_bit_cast(float, __builtin_amdgcn_update_dpp(__builtin_bit_cast(int, v), __builtin_bit_cast(int, v), CTRL, 0xF, 0xF, false));
}
__device__ __forceinline__ float xor16_sum(float v) { const u32x2 r = __builtin_amdgcn_permlane16_swap(__builtin_bit_cast(unsigned, v), __builtin_bit_cast(unsigned, v), false, false); return __builtin_bit_cast(float, r.x) + __builtin_bit_cast(float, r.y); }
__device__ __forceinline__ float xor32_sum(float v) { const u32x2 r = __builtin_amdgcn_permlane32_swap(__builtin_bit_cast(unsigned, v), __builtin_bit_cast(unsigned, v), false, false); return __builtin_bit_cast(float, r.x) + __builtin_bit_cast(float, r.y); }
__device__ __forceinline__ float xor32_max(float v) { const u32x2 r = __builtin_amdgcn_permlane32_swap(__builtin_bit_cast(unsigned, v), __builtin_bit_cast(unsigned, v), false, false); return fmaxf(__builtin_bit_cast(float, r.x), __builtin_bit_cast(float, r.y)); }
__device__ __forceinline__ float wave_sum(float v) {
    v += dpp_mov<0xB1>(v);
    v += dpp_mov<0x4E>(v);
    v += dpp_mov<0x141>(v);
    v += dpp_mov<0x140>(v);
    const int b = __builtin_bit_cast(int, v);
    const float r0 = __builtin_bit_cast(float, __builtin_amdgcn_readlane(b, 0)), r1 = __builtin_bit_cast(float, __builtin_amdgcn_readlane(b, 16));
    const float r2 = __builtin_bit_cast(float, __builtin_amdgcn_readlane(b, 32)), r3 = __builtin_bit_cast(float, __builtin_amdgcn_readlane(b, 48));
    return (r0 + r1) + (r2 + r3);
}

namespace pg8 {
constexpr int BM = 256, BK = 64, HALF = 128, HTB = HALF * BK * 2, NXCD = 8, WGM = 8;
__device__ __forceinline__ int lds_byte(int r, int c) { const int st = (r >> 4) * 2 + (c >> 5), rr = r & 15, cc = c & 31, ob = rr * 64 + cc * 2; return st * 1024 + (ob ^ (((ob >> 9) & 1) << 5)); }
__device__ __forceinline__ void stage_rc(int b, int& R, int& C) { const int st = b / 1024, sb = b % 1024, swz = sb ^ (((sb >> 9) & 1) << 5); R = (st >> 1) * 16 + swz / 64; C = (st & 1) * 32 + (swz % 64) / 2; }
__device__ __forceinline__ int perm32(int rho) { const int n = rho >> 4, i = rho & 15; return 8 * (i >> 2) + 4 * n + (i & 3); }

struct Unit { int pm, pn, acol; };
struct Gemm { const bf16_t* A; const bf16_t* Bt; int lda, K; };

struct StaticOrder {
    int nM, nN, nwg, G, c;
    __device__ void init(int M, int N, int G_, int c_) { nM = M / BM; nN = N / BM; nwg = nM * nN; G = G_; c = c_; }
    __device__ bool next(int i, Unit& u) const {
        const long L = (long)i * G + c; if (L >= nwg) return false;
        int wgid = (int)L; { const int q = nwg / NXCD, r = nwg % NXCD, xcd = wgid % NXCD, off = wgid / NXCD; wgid = (xcd < r ? xcd * (q + 1) : r * (q + 1) + (xcd - r) * q) + off; }
        const int nig = WGM * nN, gid = wgid / nig, fm = gid * WGM, gsz = (nM - fm) < WGM ? (nM - fm) : WGM;
        u.pm = fm + ((wgid % nig) % gsz); u.pn = (wgid % nig) / gsz; u.acol = 0; return true;
    }
};
struct BranchOrder {
    int G, c, loc, xx, xr;
    __device__ bool next(int i, Unit& u) const {
        const int n = i % 3; int grp;
        if (loc) { const int k = i / 3; if (k >= 2) return false; const int gl = xr + 32 * k; grp = ((16 * xx + (gl >> 2)) << 2) | (gl & 3); }
        else { grp = (i / 3) * G + c; if (grp >= (T / 256) * 4) return false; }
        u.pm = grp >> 2; u.pn = n * 4 + (grp & 3); u.acol = n * 1024; return true;
    }
};

__device__ __forceinline__ unsigned cvt_pk_bf16(float lo, float hi) { unsigned r; asm volatile("v_cvt_pk_bf16_f32 %0, %1, %2" : "=v"(r) : "v"(lo), "v"(hi)); return r; }

#define EPI_LOOP_BEGIN \
    _Pragma("unroll") for (int ai = 0; ai < 2; ++ai) _Pragma("unroll") for (int m = 0; m < 4; ++m) { const int row = u.pm * BM + ai * HALF + wr * 64 + m * 16 + fr; \
    _Pragma("unroll") for (int bj = 0; bj < 2; ++bj) { const int cl = bj * HALF + wc * 32 + 8 * fq; f32x4 v0 = acc[ai][bj][m][0], v1 = acc[ai][bj][m][1];
#define EPI_LOOP_END } }

struct EpiZ {
    bf16_t* Z; const float* bias;
    __device__ __forceinline__ void operator()(const f32x4 (&acc)[2][2][4][2], const Unit& u, int wr, int wc, int fr, int fq) const {
        const int pn = u.pn; const int act = (pn < 4 || pn == 8 || pn == 9) ? 1 : (pn >= 10 ? 2 : 0);
        EPI_LOOP_BEGIN
            const int col = pn * BM + cl; const f32x4 b0 = *(const f32x4*)(bias + col), b1 = *(const f32x4*)(bias + col + 4);
            v0 = v0 + b0; v1 = v1 + b1;
            if (act == 1) {
#pragma unroll
                for (int e = 0; e < 4; ++e) { v0[e] = gelu_t(v0[e]); v1[e] = gelu_t(v1[e]); }
            } else if (act == 2) {
#pragma unroll
                for (int e = 0; e < 4; ++e) { v0[e] = sigmoidf_(v0[e]); v1[e] = sigmoidf_(v1[e]); }
            }
            u32x4 w; w.x = cvt_pk_bf16(v0[0], v0[1]); w.y = cvt_pk_bf16(v0[2], v0[3]); w.z = cvt_pk_bf16(v1[0], v1[1]); w.w = cvt_pk_bf16(v1[2], v1[3]);
            *(u32x4*)(Z + (size_t)row * ZP + col) = w;
        EPI_LOOP_END
    }
};
struct EpiUp {
    bf16_t* Hb; bf16_t* Z;
    __device__ __forceinline__ void operator()(const f32x4 (&acc)[2][2][4][2], const Unit& u, int wr, int wc, int fr, int fq) const {
        const int pn = u.pn;
        if (pn < 3) {
            bf16_t* base = Hb + pn * BM;
            EPI_LOOP_BEGIN
                v0 = v0 * QSCALE; v1 = v1 * QSCALE;
                u32x4 w; w.x = cvt_pk_bf16(v0[0], v0[1]); w.y = cvt_pk_bf16(v0[2], v0[3]); w.z = cvt_pk_bf16(v1[0], v1[1]); w.w = cvt_pk_bf16(v1[2], v1[3]);
                *(u32x4*)(base + (size_t)row * 1024 + cl) = w;
            EPI_LOOP_END
        } else {
            bf16_t* base = pn < 5 ? Z + ZC_KN + (pn - 3) * BM : Z + ZC_V + (pn - 5) * BM;
            EPI_LOOP_BEGIN
                u32x4 w; w.x = cvt_pk_bf16(v0[0], v0[1]); w.y = cvt_pk_bf16(v0[2], v0[3]); w.z = cvt_pk_bf16(v1[0], v1[1]); w.w = cvt_pk_bf16(v1[2], v1[3]);
                *(u32x4*)(base + (size_t)row * ZP + cl) = w;
            EPI_LOOP_END
        }
    }
};
struct EpiBranch {
    bf16_t* Mg; const bf16_t* Z;
    __device__ __forceinline__ void operator()(const f32x4 (&acc)[2][2][4][2], const Unit& u, int wr, int wc, int fr, int fq) const {
        const int n = u.pn >> 2, pnr = u.pn & 3;
        const int col0 = pnr * BM + wc * 32 + 8 * fq;
#pragma unroll
        for (int ai = 0; ai < 2; ++ai) {
            u32x4 g[4][2], o[4][2];
#pragma unroll
            for (int m = 0; m < 4; ++m)
#pragma unroll
                for (int bj = 0; bj < 2; ++bj) { const int row = u.pm * BM + ai * HALF + wr * 64 + m * 16 + fr, col = col0 + bj * HALF;
                    g[m][bj] = *(const u32x4*)(Z + (size_t)row * ZP + ZC_GATE + n * 1024 + col);
                    if (n > 0) o[m][bj] = *(const u32x4*)(Mg + (size_t)row * 1024 + col); }
#pragma unroll
            for (int m = 0; m < 4; ++m)
#pragma unroll
                for (int bj = 0; bj < 2; ++bj) { const int row = u.pm * BM + ai * HALF + wr * 64 + m * 16 + fr, col = col0 + bj * HALF;
                    f32x4 v0 = acc[ai][bj][m][0], v1 = acc[ai][bj][m][1]; const u32x4 gg = g[m][bj];
                    v0[0] *= bflo(gg.x); v0[1] *= bfhi(gg.x); v0[2] *= bflo(gg.y); v0[3] *= bfhi(gg.y); v1[0] *= bflo(gg.z); v1[1] *= bfhi(gg.z); v1[2] *= bflo(gg.w); v1[3] *= bfhi(gg.w);
                    if (n > 0) { const u32x4 oo = o[m][bj];
                        v0[0] += bflo(oo.x); v0[1] += bfhi(oo.x); v0[2] += bflo(oo.y); v0[3] += bfhi(oo.y); v1[0] += bflo(oo.z); v1[1] += bfhi(oo.z); v1[2] += bflo(oo.w); v1[3] += bfhi(oo.w); }
                    u32x4 w; w.x = cvt_pk_bf16(v0[0], v0[1]); w.y = cvt_pk_bf16(v0[2], v0[3]); w.z = cvt_pk_bf16(v1[0], v1[1]); w.w = cvt_pk_bf16(v1[2], v1[3]);
                    *(u32x4*)(Mg + (size_t)row * 1024 + col) = w; }
        }
    }
};
struct EpiRes {
    const float* Xin; float* Xout; const float* gmod; const float* bias;
    const float* stat; const float* lg; const float* lb;
    __device__ __forceinline__ void operator()(const f32x4 (&acc)[2][2][4][2], const Unit& u, int wr, int wc, int fr, int fq) const {
        const float* gm = gmod + (u.pm >> 5) * 6144;
        const int col0 = u.pn * BM + wc * 32 + 8 * fq;
#pragma unroll
        for (int ai = 0; ai < 2; ++ai)
#pragma unroll
            for (int mh = 0; mh < 2; ++mh) {
                f32x4 xa[2][2], xb[2][2]; f32x2 sm[2];
#pragma unroll
                for (int mm = 0; mm < 2; ++mm) { const int row = u.pm * BM + ai * HALF + wr * 64 + (2 * mh + mm) * 16 + fr;
                    sm[mm] = stat ? *(const f32x2*)(stat + 2 * row) : (f32x2){0.f, 1.f};
#pragma unroll
                    for (int bj = 0; bj < 2; ++bj) { const int col = col0 + bj * HALF;
                        xa[mm][bj] = *(const f32x4*)(Xin + (size_t)row * DM + col); xb[mm][bj] = *(const f32x4*)(Xin + (size_t)row * DM + col + 4); } }
#pragma unroll
                for (int bj = 0; bj < 2; ++bj) { const int col = col0 + bj * HALF;
                    f32x4 g0 = *(const f32x4*)(gm + col) + 1.f, g1 = *(const f32x4*)(gm + col + 4) + 1.f;
                    f32x4 b0 = (f32x4){0.f, 0.f, 0.f, 0.f}, b1 = b0;
                    if (bias) { b0 = *(const f32x4*)(bias + col); b1 = *(const f32x4*)(bias + col + 4); }
                    f32x4 l0 = (f32x4){1.f, 1.f, 1.f, 1.f}, l1 = l0, c0 = (f32x4){0.f, 0.f, 0.f, 0.f}, c1 = c0;
                    if (stat) { l0 = *(const f32x4*)(lg + col); l1 = *(const f32x4*)(lg + col + 4); c0 = *(const f32x4*)(lb + col); c1 = *(const f32x4*)(lb + col + 4); }
#pragma unroll
                    for (int mm = 0; mm < 2; ++mm) { const int m = 2 * mh + mm; const int row = u.pm * BM + ai * HALF + wr * 64 + m * 16 + fr;
                        f32x4 x0 = xa[mm][bj], x1 = xb[mm][bj];
                        if (stat) { x0 = (x0 - sm[mm].x) * sm[mm].y * l0 + c0; x1 = (x1 - sm[mm].x) * sm[mm].y * l1 + c1; }
                        *(f32x4*)(Xout + (size_t)row * DM + col) = x0 * ALPHA + g0 * (acc[ai][bj][m][0] + b0);
                        *(f32x4*)(Xout + (size_t)row * DM + col + 4) = x1 * ALPHA + g1 * (acc[ai][bj][m][1] + b1); } }
            }
    }
};
struct EpiFF1 {
    bf16_t* F1; const float* bias;
    __device__ __forceinline__ void operator()(const f32x4 (&acc)[2][2][4][2], const Unit& u, int wr, int wc, int fr, int fq) const {
        EPI_LOOP_BEGIN
            const int col = u.pn * BM + cl;
            v0 = v0 + *(const f32x4*)(bias + col); v1 = v1 + *(const f32x4*)(bias + col + 4);
#pragma unroll
            for (int e = 0; e < 4; ++e) { const float a = fmaxf(v0[e], 0.f), b = fmaxf(v1[e], 0.f); v0[e] = a * a; v1[e] = b * b; }
            u32x4 w; w.x = cvt_pk_bf16(v0[0], v0[1]); w.y = cvt_pk_bf16(v0[2], v0[3]); w.z = cvt_pk_bf16(v1[0], v1[1]); w.w = cvt_pk_bf16(v1[2], v1[3]);
            *(u32x4*)(F1 + (size_t)row * ZP + col) = w;
        EPI_LOOP_END
    }
};

template <class Epi, class Sched>
__device__ __forceinline__ void gemm_phase(LAS unsigned char* lds, const Gemm g, const Sched& S, const Epi& E) {
    int tid_ = threadIdx.x; asm volatile("" : "+v"(tid_));
    const int tid = tid_, wid = __builtin_amdgcn_readfirstlane(tid >> 6), lane = tid & 63, wr = wid >> 2, wc = wid & 3, fr = lane & 15, fq = lane >> 4;
    const int K = g.K, nt = K / BK, lda = g.lda;
    unsigned voffA[2], voffB[2];
#pragma unroll
    for (int i = 0; i < 2; ++i) { int R, C; stage_rc(tid * 16 + i * 8192, R, C); const int Rb = (R & ~31) + perm32(R & 31);
        voffA[i] = (unsigned)(R * lda + C) * 2u; voffB[i] = (unsigned)(Rb * K + C) * 2u; }
    const size_t kstep = (size_t)(BK * 2);
    const size_t hstepA = (size_t)HALF * lda * 2, hstepB = (size_t)HALF * K * 2;
    const size_t tstepA = 2 * hstepA, tstepB = 2 * hstepB;
    const unsigned ldsw = (unsigned)wid * 1024u;
    const int aoff = lds_byte(wr * 64 + fr, fq * 8), boff = lds_byte(wc * 32 + fr, fq * 8);
#define PG8_SA(b, h) (((b) * 2 + (h)) * HTB)
#define PG8_SB(b, h) ((4 + (b) * 2 + (h)) * HTB)
#define PG8_STAGE(bufoff, gbase, voff) do { _Pragma("unroll") for (int _i = 0; _i < 2; ++_i) \
        __builtin_amdgcn_global_load_lds((const unsigned*)((const char*)(gbase) + (voff)[_i]), (LAS unsigned*)(lds + (bufoff) + ldsw + _i * 8192), 16, 0, 0); } while (0)
#define PG8_LDA(dst, b, h) do { _Pragma("unroll") for (int m = 0; m < 4; ++m) _Pragma("unroll") for (int k = 0; k < 2; ++k) dst[m][k] = *(const LAS bf16x8*)(lds + PG8_SA(b, h) + aoff + m * 2048 + k * 1024); } while (0)
#define PG8_LDB(dst, b, h) do { _Pragma("unroll") for (int n = 0; n < 2; ++n) _Pragma("unroll") for (int k = 0; k < 2; ++k) dst[n][k] = *(const LAS bf16x8*)(lds + PG8_SB(b, h) + boff + n * 2048 + k * 1024); } while (0)
#define PG8_MMA(ai, bj, At, Bt) do { __builtin_amdgcn_s_setprio(1); _Pragma("unroll") for (int m = 0; m < 4; ++m) _Pragma("unroll") for (int n = 0; n < 2; ++n) _Pragma("unroll") for (int k = 0; k < 2; ++k) \
        acc[ai][bj][m][n] = __builtin_amdgcn_mfma_f32_16x16x32_bf16(Bt[n][k], At[m][k], acc[ai][bj][m][n], 0, 0, 0); __builtin_amdgcn_s_setprio(0); } while (0)
#define PG8_WAIT_V(n) asm volatile("s_waitcnt vmcnt(" #n ")" ::: "memory")
#define PG8_WAIT_L(n) asm volatile("s_waitcnt lgkmcnt(" #n ")" ::: "memory")
#define PG8_BAR __builtin_amdgcn_s_barrier()
#define PG8_SCHED __builtin_amdgcn_sched_barrier(0)
    Unit cur, nxt; int ui = 0;
    if (!S.next(0, cur)) return;
    f32x4 acc[2][2][4][2];
#pragma unroll
    for (int a = 0; a < 2; ++a)
#pragma unroll
        for (int b = 0; b < 2; ++b)
#pragma unroll
            for (int m = 0; m < 4; ++m)
#pragma unroll
                for (int n = 0; n < 2; ++n) acc[a][b][m][n] = (f32x4){0.f, 0.f, 0.f, 0.f};
    bf16x8 At[4][2], B0[2][2], B1[2][2];
    const char* cA = (const char*)g.A + (size_t)cur.pm * tstepA + (size_t)cur.acol * 2; const char* cB = (const char*)g.Bt + (size_t)cur.pn * tstepB;
    PG8_STAGE(PG8_SB(0, 0), cB, voffB); PG8_STAGE(PG8_SB(0, 1), cB + hstepB, voffB); PG8_STAGE(PG8_SA(0, 0), cA, voffA); PG8_STAGE(PG8_SA(0, 1), cA + hstepA, voffA);
    if (wr == 1) PG8_BAR;
    PG8_WAIT_V(2); PG8_BAR;
    PG8_STAGE(PG8_SB(1, 0), cB + kstep, voffB); PG8_STAGE(PG8_SA(1, 0), cA + kstep, voffA); PG8_STAGE(PG8_SB(1, 1), cB + hstepB + kstep, voffB);
    PG8_WAIT_V(6); PG8_BAR;
    for (;;) {
        const bool has_next = S.next(ui + 1, nxt);
        const char* nA = has_next ? (const char*)g.A + (size_t)nxt.pm * tstepA + (size_t)nxt.acol * 2 : cA; const char* nB = has_next ? (const char*)g.Bt + (size_t)nxt.pn * tstepB : cB;
#pragma unroll 1
        for (int t = 0; t < nt; t += 2) {
            const bool last = (t == nt - 2);
            const char* a1 = cA + (size_t)(t + 1) * kstep;
            const char* a2 = last ? nA : cA + (size_t)(t + 2) * kstep; const char* b2 = last ? nB : cB + (size_t)(t + 2) * kstep;
            const char* a3 = a2 + kstep; const char* b3 = b2 + kstep;
            PG8_LDB(B0, 0, 0); PG8_LDB(B1, 0, 1); PG8_SCHED; PG8_LDA(At, 0, 0); PG8_STAGE(PG8_SA(1, 1), a1 + hstepA, voffA);
            PG8_WAIT_V(8); PG8_WAIT_L(0); PG8_BAR; PG8_MMA(0, 0, At, B0); PG8_MMA(0, 1, At, B1); PG8_BAR; PG8_SCHED;
            PG8_LDA(At, 0, 1); PG8_STAGE(PG8_SB(0, 0), b2, voffB); PG8_STAGE(PG8_SB(0, 1), b2 + hstepB, voffB); PG8_STAGE(PG8_SA(0, 0), a2, voffA);
            PG8_WAIT_V(8); PG8_WAIT_L(0); PG8_BAR; PG8_MMA(1, 0, At, B0); PG8_MMA(1, 1, At, B1); PG8_BAR; PG8_SCHED;
            PG8_LDB(B0, 1, 0); PG8_LDB(B1, 1, 1); PG8_SCHED; PG8_LDA(At, 1, 0); PG8_STAGE(PG8_SA(0, 1), a2 + hstepA, voffA);
            PG8_WAIT_V(8); PG8_WAIT_L(0); PG8_BAR; PG8_MMA(0, 0, At, B0); PG8_MMA(0, 1, At, B1); PG8_BAR; PG8_SCHED;
            PG8_LDA(At, 1, 1); PG8_STAGE(PG8_SB(1, 0), b3, voffB); PG8_STAGE(PG8_SB(1, 1), b3 + hstepB, voffB); PG8_STAGE(PG8_SA(1, 0), a3, voffA);
            PG8_WAIT_V(8); PG8_WAIT_L(0); PG8_BAR; PG8_MMA(1, 0, At, B0); PG8_MMA(1, 1, At, B1); PG8_BAR; PG8_SCHED;
        }
        if (wr == 0) PG8_BAR;
        E(acc, cur, wr, wc, fr, fq);
        if (!has_next) break;
#pragma unroll
        for (int a = 0; a < 2; ++a)
#pragma unroll
            for (int b = 0; b < 2; ++b)
#pragma unroll
                for (int m = 0; m < 4; ++m)
#pragma unroll
                    for (int n = 0; n < 2; ++n) acc[a][b][m][n] = (f32x4){0.f, 0.f, 0.f, 0.f};
        cur = nxt; cA = nA; cB = nB; ++ui;
        if (wr == 1) PG8_BAR;
    }
    PG8_WAIT_V(0);
    PG8_BAR;
#undef PG8_SA
#undef PG8_SB
#undef PG8_STAGE
#undef PG8_LDA
#undef PG8_LDB
#undef PG8_MMA
#undef PG8_WAIT_V
#undef PG8_WAIT_L
#undef PG8_BAR
#undef PG8_SCHED
}
}

#define XB_TMO      128
#define XB_XCNT(j)  (256  + 64 * (j))
#define XB_XSUB(j)  (1280 + 64 * (j))
#define XB_XGEN(j)  (2304 + 64 * (j))
#define XB_TOP      3328
#define XB_TOPGEN   3392
#define XCD_BAR_WORDS 3456
#define XB_LSUB(j)  (3456 + 32 * (j))
#define XB_LGEN(j)  (3712 + 32 * (j))
#define XB_BAD      4000
#define XB_SPIN_CAP (1u << 18)

__device__ __forceinline__ unsigned xb_ld(unsigned* p)              { return __hip_atomic_load(p, __ATOMIC_RELAXED, __HIP_MEMORY_SCOPE_AGENT); }
__device__ __forceinline__ unsigned xb_add(unsigned* p, unsigned v) { return __hip_atomic_fetch_add(p, v, __ATOMIC_RELAXED, __HIP_MEMORY_SCOPE_AGENT); }
__device__ __forceinline__ unsigned xb_xcc_id() { return (unsigned)__builtin_amdgcn_s_getreg((3 << 11) | 20) & 0xFu; }
#define XB_SPIN(cond, bar) do { unsigned _sp = 0; while (cond) { __builtin_amdgcn_s_sleep(1); \
    if ((++_sp & 255u) == 0u) { if (xb_ld(&(bar)[XB_TMO])) break; if (_sp > XB_SPIN_CAP) { atomicAdd(&(bar)[XB_TMO], 1u); break; } } } } while (0)

struct XcdBarrier {
    unsigned* bar; unsigned x;
    volatile LAS unsigned* st;
};

__device__ __forceinline__ XcdBarrier xcd_barrier_post(unsigned* bar, volatile LAS unsigned* st) {
    XcdBarrier b; b.bar = bar; b.x = xb_xcc_id(); b.st = st;
    if (threadIdx.x == 0) (void)xb_add(&bar[XB_XCNT(b.x)], 1u);
    return b;
}
__device__ __forceinline__ void xcd_barrier_complete(unsigned* bar, unsigned x, unsigned& nloc, unsigned& nx) {
    const unsigned G = gridDim.x * gridDim.y * gridDim.z;
    unsigned sum, cnt, mine, sp = 0u;
    for (;;) {
        sum = 0u; cnt = 0u; mine = 0u;
#pragma unroll
        for (unsigned j = 0; j < 16; ++j) { const unsigned c = xb_ld(&bar[XB_XCNT(j)]); sum += c; cnt += (c > 0u) ? 1u : 0u; mine = (j == x) ? c : mine; }
        if (sum == G) break;
        __builtin_amdgcn_s_sleep(1);
        if ((++sp & 255u) == 0u) { if (xb_ld(&bar[XB_TMO])) break; if (sp > XB_SPIN_CAP) { atomicAdd(&bar[XB_TMO], 1u); break; } }
    }
    nloc = mine > 0u ? mine : 1u; nx = cnt > 0u ? cnt : 1u;
}

__device__ __forceinline__ void xcd_barrier(const XcdBarrier& b) {
    asm volatile("s_waitcnt vmcnt(0)" ::: "memory");
    __syncthreads();
    if (threadIdx.x == 0) {
        unsigned* bar = b.bar;
        __builtin_amdgcn_s_waitcnt(0);
        unsigned nloc = b.st[0], nx = b.st[1];
        if (nloc == 0u) { xcd_barrier_complete(bar, b.x, nloc, nx); b.st[0] = nloc; b.st[1] = nx; }
        const unsigned old = xb_add(&bar[XB_XSUB(b.x)], 1u);
        const unsigned gen = old / nloc;
        if (old + 1u == (gen + 1u) * nloc) {
            __builtin_amdgcn_fence(__ATOMIC_RELEASE, "agent");
            asm volatile("s_waitcnt vmcnt(0)" ::: "memory");
            const unsigned og = xb_add(&bar[XB_TOP], 1u);
            const unsigned tg = og / nx;
            if (og + 1u == (tg + 1u) * nx) xb_add(&bar[XB_TOPGEN], 1u);
            else XB_SPIN(xb_ld(&bar[XB_TOPGEN]) == tg, bar);
            __builtin_amdgcn_fence(__ATOMIC_ACQUIRE, "agent");
            xb_add(&bar[XB_XGEN(b.x)], 1u);
            asm volatile("s_waitcnt vmcnt(0)" ::: "memory");
        } else {
            XB_SPIN(xb_ld(&bar[XB_XGEN(b.x)]) == gen, bar);
            __builtin_amdgcn_fence(__ATOMIC_ACQUIRE, "agent");
            asm volatile("s_waitcnt vmcnt(0)" ::: "memory");
        }
    }
    __syncthreads();
}


__device__ __forceinline__ void xcd_local_barrier(const XcdBarrier& b) {
    asm volatile("s_waitcnt vmcnt(0)" ::: "memory");
    __syncthreads();
    if (threadIdx.x == 0) {
        unsigned* bar = b.bar;
        __builtin_amdgcn_s_waitcnt(0);
        const unsigned nloc = b.st[0] ? b.st[0] : 1u;
        const unsigned old = xb_add(&bar[XB_LSUB(b.x)], 1u);
        const unsigned gen = old / nloc;
        if (old + 1u == (gen + 1u) * nloc) xb_add(&bar[XB_LGEN(b.x)], 1u);
        else XB_SPIN(xb_ld(&bar[XB_LGEN(b.x)]) == gen, bar);
        __builtin_amdgcn_fence(__ATOMIC_ACQUIRE, "agent");
        asm volatile("s_waitcnt vmcnt(0)" ::: "memory");
    }
    __syncthreads();
}

struct Params { const float* in[29]; float* out; unsigned char* ws; int ph_lo, ph_hi; };
enum { I_X = 0, I_C, I_ADAW, I_ADAB, I_INW, I_INB, I_GMLNG, I_GMLNB, I_GMWS, I_GMBS, I_QNG, I_WUQ, I_KVNG, I_WUKV, I_CONVW, I_CONVB, I_WR, I_BR, I_WI, I_BI, I_LAM,
       I_BRW, I_MIXW, I_W1, I_B1, I_W2, I_B2, I_LNG, I_LNB };

__device__ __forceinline__ int map_in(int n) { return n < 1440 ? n : n + 96; }
__device__ __forceinline__ int map_q(int n) { const int h = n / 96, d = n % 96; if (d < 64) return n; const int i = d - 64; return h * 96 + 64 + (i < 16 ? 2 * i : 2 * (i - 16) + 1); }
__device__ __forceinline__ int map_kv(int n) { const int h = n >> 7, d = n & 127; return d < 64 ? 768 + h * 64 + d : 1280 + h * 64 + (d - 64); }
template <int MAPK>
__device__ __forceinline__ void transpose_item(const float* __restrict__ W, int N, bf16_t* WT, int ldk, int kofs, int rowbase, float* scr, int item, int lane) {
    const int nblk = N / 32, kb = item / nblk, nb = item % nblk, k0 = 64 * kb, n0 = 32 * nb;
#pragma unroll 8
    for (int i = 0; i < 32; ++i) { const int kk = 2 * i + (lane >> 5); scr[kk * 33 + (lane & 31)] = W[(size_t)(k0 + kk) * N + n0 + (lane & 31)]; }
    const int c = lane & 7;
#pragma unroll
    for (int j = 0; j < 4; ++j) { const int n = (lane >> 3) + 8 * j; const float* s = scr + (8 * c) * 33 + n;
        u32x4 o; o.x = pk2(s[0 * 33], s[1 * 33]); o.y = pk2(s[2 * 33], s[3 * 33]); o.z = pk2(s[4 * 33], s[5 * 33]); o.w = pk2(s[6 * 33], s[7 * 33]);
        const int nn = n0 + n; const int dr = rowbase + (MAPK == 1 ? map_in(nn) : MAPK == 2 ? map_q(nn) : MAPK == 3 ? map_kv(nn) : nn);
        *(u32x4*)(WT + (size_t)dr * ldk + kofs + k0 + 8 * c) = o; }
}

template <int PART>
__device__ __forceinline__ void prologue(const Params& p, unsigned char* lds) {
    const int tid = threadIdx.x, lane = tid & 63, wave = tid >> 6, G = gridDim.x;
    unsigned char* ws = p.ws;
    const int gw = blockIdx.x * 8 + wave, ngw = G * 8;
    float* scr = (float*)(lds + wave * 16384);
    constexpr int IT_IN = 16 * 173, IT_Q = 4 * 24, IT_KV = 2 * 32, IT_BR = 8 * 32, IT_MIX = 16 * 32, IT_W1 = 16 * 128, IT_W2 = 64 * 32;
    constexpr int IT_LAYER = IT_IN + IT_Q + IT_KV + 3 * IT_BR + IT_MIX + IT_W1 + IT_W2;
    if (PART == 1) for (int it = gw; it < 2 * IT_LAYER; it += ngw) {
        const int l = it / IT_LAYER; int r = it % IT_LAYER;
        bf16_t* win = (bf16_t*)(ws + WS_WIN) + (size_t)l * ZP * 1024; bf16_t* wup = (bf16_t*)(ws + WS_WUP) + (size_t)l * NUP * KUP;
        bf16_t* wbr = (bf16_t*)(ws + WS_WBR) + (size_t)l * 3072 * 512; bf16_t* wmix = (bf16_t*)(ws + WS_WMIX) + (size_t)l * 1024 * 1024;
        bf16_t* w1 = (bf16_t*)(ws + WS_W1) + (size_t)l * FF * 1024; bf16_t* w2 = (bf16_t*)(ws + WS_W2) + (size_t)l * 1024 * FF;
        if (r < IT_IN) { transpose_item<1>(p.in[I_INW] + (size_t)l * 1024 * NIN, NIN, win, 1024, 0, 0, scr, r, lane); continue; } r -= IT_IN;
        if (r < IT_Q) { transpose_item<2>(p.in[I_WUQ] + (size_t)l * 256 * 768, 768, wup, KUP, 0, 0, scr, r, lane); continue; } r -= IT_Q;
        if (r < IT_KV) { transpose_item<3>(p.in[I_WUKV] + (size_t)l * 128 * 1024, 1024, wup, KUP, 256, 0, scr, r, lane); continue; } r -= IT_KV;
        if (r < 3 * IT_BR) { const int n = r / IT_BR; transpose_item<0>(p.in[I_BRW] + ((size_t)l * 3 + n) * 512 * 1024, 1024, wbr, 512, 0, n * 1024, scr, r % IT_BR, lane); continue; } r -= 3 * IT_BR;
        if (r < IT_MIX) { transpose_item<0>(p.in[I_MIXW] + (size_t)l * 1024 * 1024, 1024, wmix, 1024, 0, 0, scr, r, lane); continue; } r -= IT_MIX;
        if (r < IT_W1) { transpose_item<0>(p.in[I_W1] + (size_t)l * 1024 * FF, FF, w1, 1024, 0, 0, scr, r, lane); continue; } r -= IT_W1;
        transpose_item<0>(p.in[I_W2] + (size_t)l * FF * 1024, 1024, w2, FF, 0, 0, scr, r, lane);
    }
    if (PART == 1) return;
    const int gt = blockIdx.x * NTHREADS + tid, ngt = G * NTHREADS;
    for (int i = gt; i < 2 * NUP * KUP; i += ngt) { const int l = i / (NUP * KUP), r = (i / KUP) % NUP, k = i % KUP;
        if ((r < 768) ? (k >= 256) : (k < 256)) ((bf16_t*)(ws + WS_WUP))[i] = 0; (void)l; }
    for (int i = gt; i < 2 * 96 * 1024; i += ngt) { const int l = i / (96 * 1024), r = i % (96 * 1024); ((bf16_t*)(ws + WS_WIN))[(size_t)l * ZP * 1024 + (size_t)1440 * 1024 + r] = 0; }
    for (int i = gt; i < 2 * 65536; i += ngt) { const int gi = i >> 16, r = i & 65535, ln = r >> 12, d = (r >> 6) & 63, c = r & 63;
        ((bf16_t*)(ws + WS_LRUW))[i] = (bf16_t)f2bf(p.in[gi ? I_WI : I_WR][(size_t)ln * 4096 + c * 64 + d]); }
    for (int i = gt; i < 2 * 4 * 128 * 128; i += ngt) { const int ii = (i >> 7) & 127, jj = i & 127;
        ((bf16_t*)(ws + WS_GMW))[i] = (ii < 64 && jj >= 64) ? (bf16_t)0 : (bf16_t)f2bf(p.in[I_GMWS][i]); }
    for (int i = gt; i < 2 * ZP; i += ngt) { const int l = i / ZP, c = i % ZP; float v = 0.f;
        if (c < 1440) v = p.in[I_INB][l * NIN + c]; else if (c >= 1536) v = p.in[I_INB][l * NIN + c - 96];
        ((float*)(ws + WS_BIASP))[i] = v; }
    for (int i = gt; i < SEQ * 16; i += ngt) { const int pos = i >> 4, j = i & 15;
        const float inv = (float)pow(10000.0, -(double)(2 * j) / 32.0); const float ang = (float)pos * inv;
        ((float*)(ws + WS_ROPE))[i] = (float)cos((double)ang); ((float*)(ws + WS_ROPE))[SEQ * 16 + i] = (float)sin((double)ang); }
    __syncthreads();
    float* sc = (float*)lds;
    float* red = (float*)(lds + 16384);
    for (int i = tid; i < 4096; i += NTHREADS) { const float v = p.in[I_C][i]; sc[i] = v / (1.f + __expf(-v)); }
    __syncthreads();
    for (int u = blockIdx.x; u < 2 * 96; u += G) {
        const int l = u / 96, n = (u % 96) * 64 + (tid & 63), kp = tid >> 6;
        const float* w = p.in[I_ADAW] + (size_t)l * 1024 * 6144 + n;
        float a0 = 0.f, a1 = 0.f, a2 = 0.f, a3 = 0.f;
        for (int k = kp * 128; k < kp * 128 + 128; ++k) { const float wv = w[(size_t)k * 6144]; a0 += sc[k] * wv; a1 += sc[1024 + k] * wv; a2 += sc[2048 + k] * wv; a3 += sc[3072 + k] * wv; }
        red[(kp * 4 + 0) * 64 + (tid & 63)] = a0; red[(kp * 4 + 1) * 64 + (tid & 63)] = a1; red[(kp * 4 + 2) * 64 + (tid & 63)] = a2; red[(kp * 4 + 3) * 64 + (tid & 63)] = a3;
        __syncthreads();
        if (tid < 256) { const int b = tid >> 6, c = tid & 63; float s = 0.f;
#pragma unroll
            for (int q = 0; q < 8; ++q) s += red[(q * 4 + b) * 64 + c];
            const int nn = (u % 96) * 64 + c;
            ((float*)(ws + WS_MOD))[(l * 4 + b) * 6144 + nn] = s + p.in[I_ADAB][l * 6144 + nn]; }
        __syncthreads();
    }
}

struct LnRows { int gw, ngw, rbase, rend; };
__device__ __forceinline__ void ln_pass(const float* src, float* dstx, const float* lg, const float* lb, const float* msc, const float* msh, bf16_t* Hout, float* statout, const LnRows R) {
    const int lane = threadIdx.x & 63;
    for (int row = R.rbase + R.gw; row < R.rend; row += R.ngw) {
        const f32x4* xr = (const f32x4*)(src + (size_t)row * DM) + lane;
        f32x4 v[4];
#pragma unroll
        for (int j = 0; j < 4; ++j) v[j] = xr[64 * j];
        if (lg) {
            float s = 0.f;
#pragma unroll
            for (int j = 0; j < 4; ++j) s += (v[j].x + v[j].y) + (v[j].z + v[j].w);
            const float mean = wave_sum(s) * (1.f / DM); float s2 = 0.f;
#pragma unroll
            for (int j = 0; j < 4; ++j) { v[j] = v[j] - mean; s2 += (v[j].x * v[j].x + v[j].y * v[j].y) + (v[j].z * v[j].z + v[j].w * v[j].w); }
            const float rstd = 1.f / sqrtf(wave_sum(s2) * (1.f / DM) + 1e-5f);
            if (statout && lane == 0) { statout[2 * row] = mean; statout[2 * row + 1] = rstd; }
#pragma unroll
            for (int j = 0; j < 4; ++j) { const f32x4 g = *((const f32x4*)lg + lane + 64 * j), b = *((const f32x4*)lb + lane + 64 * j); v[j] = v[j] * rstd * g + b;
                if (dstx) *((f32x4*)(dstx + (size_t)row * DM) + lane + 64 * j) = v[j]; }
        }
        if (Hout) {
            float s = 0.f;
#pragma unroll
            for (int j = 0; j < 4; ++j) s += (v[j].x + v[j].y) + (v[j].z + v[j].w);
            const float mean = wave_sum(s) * (1.f / DM); float s2 = 0.f;
#pragma unroll
            for (int j = 0; j < 4; ++j) { v[j] = v[j] - mean; s2 += (v[j].x * v[j].x + v[j].y * v[j].y) + (v[j].z * v[j].z + v[j].w * v[j].w); }
            const float rstd = 1.f / sqrtf(wave_sum(s2) * (1.f / DM) + 1e-5f);
            const int b = row / SEQ;
#pragma unroll
            for (int j = 0; j < 4; ++j) { const f32x4 c = *((const f32x4*)(msc + b * 6144) + lane + 64 * j), h = *((const f32x4*)(msh + b * 6144) + lane + 64 * j);
                const f32x4 w = v[j] * rstd * (c + 1.f) + h;
                u32x2 o; o.x = pk2(w.x, w.y); o.y = pk2(w.z, w.w);
                *((u32x2*)(Hout + (size_t)row * DM) + lane + 64 * j) = o; }
        }
    }
}

__device__ __forceinline__ void latent_pass(const Params& p, int l, bf16_t* Z, bf16_t* Hb) {
    const int lane = threadIdx.x & 63, gw = blockIdx.x * 8 + (threadIdx.x >> 6), ngw = gridDim.x * 8;
    const float* qg = p.in[I_QNG] + l * 256; const float* kg = p.in[I_KVNG] + l * 128;
    const float* rc = (const float*)(p.ws + WS_ROPE); const float* rs = rc + SEQ * 16;
    for (int row = gw; row < T; row += ngw) {
        bf16_t* z = Z + (size_t)row * ZP;
        const u32x2 qa = *(const u32x2*)(z + ZC_QLAT + 4 * lane);
        float q0 = bflo(qa.x), q1 = bfhi(qa.x), q2 = bflo(qa.y), q3 = bfhi(qa.y);
        const float qr = 1.f / sqrtf(wave_sum(q0 * q0 + q1 * q1 + q2 * q2 + q3 * q3) * (1.f / 256.f) + 1e-6f);
        const f32x4 g4 = *(const f32x4*)(qg + 4 * lane);
        const unsigned ka = *(const unsigned*)(z + ZC_KVLAT + 2 * lane);
        float k0 = bflo(ka), k1 = bfhi(ka);
        const float kr = 1.f / sqrtf(wave_sum(k0 * k0 + k1 * k1) * (1.f / 128.f) + 1e-6f);
        const float kg0 = kg[2 * lane], kg1 = kg[2 * lane + 1];
        float x1 = 0.f, x2 = 0.f;
        if (lane < 16) { x1 = bf2f(z[ZC_KROPE + lane]); x2 = bf2f(z[ZC_KROPE + 16 + lane]); }
        u32x2 qo; qo.x = pk2(q0 * qr * g4.x, q1 * qr * g4.y); qo.y = pk2(q2 * qr * g4.z, q3 * qr * g4.w);
        *(u32x2*)(z + ZC_QLAT + 4 * lane) = qo;
        *(unsigned*)(z + ZC_KVLAT + 2 * lane) = pk2(k0 * kr * kg0, k1 * kr * kg1);
        if (lane < 16) { const int pos = row & (SEQ - 1); const float c = rc[pos * 16 + lane], s = rs[pos * 16 + lane];
            *(unsigned*)(Hb + (size_t)row * 1024 + 768 + 2 * lane) = pk2(x1 * c - x2 * s, x2 * c + x1 * s); }
    }
}

__device__ __forceinline__ void gmlp_mfma_unit(const Params& p, int l, bf16_t* Z, LAS unsigned char* lds, int nb) {
    const int tid = threadIdx.x, lane = tid & 63, wave = __builtin_amdgcn_readfirstlane(tid >> 6), l15 = lane & 15, lq = lane >> 4;
    LAS bf16_t* vnT = (LAS bf16_t*)lds;
    LAS float* st = (LAS float*)(lds + 34816);
    const int row0 = nb * 128;
    for (int i = 0; i < 16; ++i) { const int tok = wave * 16 + i;
        const u32x4 raw = *(const u32x4*)(Z + (size_t)(row0 + tok) * ZP + ZC_V + lane * 8);
        const float x[8] = {bflo(raw.x), bfhi(raw.x), bflo(raw.y), bfhi(raw.y), bflo(raw.z), bfhi(raw.z), bflo(raw.w), bfhi(raw.w)};
        float s = 0.f;
#pragma unroll
        for (int e = 0; e < 8; ++e) s += x[e];
        const float mean = wave_sum(s) * (1.f / 512.f); float s2 = 0.f;
#pragma unroll
        for (int e = 0; e < 8; ++e) { const float d = x[e] - mean; s2 += d * d; }
        const float rstd = 1.f / sqrtf(wave_sum(s2) * (1.f / 512.f) + 1e-5f);
        if (lane == 0) { st[tok] = mean; st[128 + tok] = rstd; } }
    __syncthreads();
    const int nks = wave < 4 ? 2 : 4, irow = 16 * wave + l15;
    for (int g = 0; g < 4; ++g) {
        const float* lng = p.in[I_GMLNG] + l * 512 + g * 128; const float* lnb = p.in[I_GMLNB] + l * 512 + g * 128;
#pragma unroll
        for (int j = 0; j < 4; ++j) { const int idx = tid + NTHREADS * j, tok = idx >> 4, c8 = (idx & 15) * 8;
            const u32x4 raw = *(const u32x4*)(Z + (size_t)(row0 + tok) * ZP + ZC_V + g * 128 + c8);
            const float x[8] = {bflo(raw.x), bfhi(raw.x), bflo(raw.y), bfhi(raw.y), bflo(raw.z), bfhi(raw.z), bflo(raw.w), bfhi(raw.w)};
            const float mean = st[tok], rstd = st[128 + tok];
#pragma unroll
            for (int e = 0; e < 8; ++e) vnT[(c8 + e) * 136 + tok] = (bf16_t)f2bf((x[e] - mean) * rstd * lng[c8 + e] + lnb[c8 + e]); }
        __syncthreads();
        bf16x8 wf[4];
        const bf16_t* wp = (const bf16_t*)(p.ws + WS_GMW) + ((size_t)(l * 4 + g) * 128 + irow) * 128 + 8 * lq;
#pragma unroll
        for (int ks = 0; ks < 4; ++ks) wf[ks] = (ks < nks) ? *(const bf16x8*)(wp + ks * 32) : (bf16x8){0, 0, 0, 0, 0, 0, 0, 0};
        const float bsv = p.in[I_GMBS][(l * 4 + g) * 128 + irow];
        bf16_t* up = Z + (size_t)(row0 + irow) * ZP + g * 128 + 4 * lq;
#pragma unroll 2
        for (int mt = 0; mt < 8; ++mt) {
            f32x4 acc = (f32x4){0.f, 0.f, 0.f, 0.f};
            const LAS bf16_t* ap = vnT + (mt * 16 + l15) * 136 + 8 * lq;
            acc = __builtin_amdgcn_mfma_f32_16x16x32_bf16(*(const LAS bf16x8*)(ap), wf[0], acc, 0, 0, 0);
            acc = __builtin_amdgcn_mfma_f32_16x16x32_bf16(*(const LAS bf16x8*)(ap + 32), wf[1], acc, 0, 0, 0);
            if (nks == 4) { acc = __builtin_amdgcn_mfma_f32_16x16x32_bf16(*(const LAS bf16x8*)(ap + 64), wf[2], acc, 0, 0, 0);
                            acc = __builtin_amdgcn_mfma_f32_16x16x32_bf16(*(const LAS bf16x8*)(ap + 96), wf[3], acc, 0, 0, 0); }
            const u32x2 uu = *(const u32x2*)(up + mt * 16);
            u32x2 o; o.x = pk2(bflo(uu.x) * (acc[0] + bsv), bfhi(uu.x) * (acc[1] + bsv)); o.y = pk2(bflo(uu.y) * (acc[2] + bsv), bfhi(uu.y) * (acc[3] + bsv));
            *(u32x2*)(up + mt * 16) = o; }
        __syncthreads();
    }
}

__device__ __forceinline__ void lru_wave_unit(const Params& p, int l, bf16_t* Z, LAS unsigned char* ldsw, int b, int ch, int n, int final) {
    const int lane = threadIdx.x & 63, l15 = lane & 15, lq = lane >> 4;
    LAS bf16_t* xcb = (LAS bf16_t*)ldsw;
    LAS float* ab = (LAS float*)(ldsw + 9216);
    float* Ps = (float*)(p.ws + WS_LRUS); float* Hs = Ps + 4 * 128 * 512;
    const size_t rowb = (size_t)b * SEQ; const int t0 = ch * 64, chn0 = n * 64;
    {
        const int c8 = (lane & 7) * 8, tr = lane >> 3, chn = chn0 + c8;
        float cw[4][8], cb[8];
#pragma unroll
        for (int e = 0; e < 8; ++e) { cb[e] = p.in[I_CONVB][l * 512 + chn + e];
#pragma unroll
            for (int k = 0; k < 4; ++k) cw[k][e] = p.in[I_CONVW][(l * 4 + k) * 512 + chn + e]; }
#pragma unroll 2
        for (int i = 0; i < 8; ++i) { const int t = tr + 8 * i; float acc[8];
#pragma unroll
            for (int e = 0; e < 8; ++e) acc[e] = cb[e];
#pragma unroll
            for (int k = 0; k < 4; ++k) { const int tt = t0 + t - 3 + k;
                if (tt >= 0) { const u32x4 raw = *(const u32x4*)(Z + (rowb + tt) * ZP + ZC_LRUX + chn);
                    const float x[8] = {bflo(raw.x), bfhi(raw.x), bflo(raw.y), bfhi(raw.y), bflo(raw.z), bfhi(raw.z), bflo(raw.w), bfhi(raw.w)};
#pragma unroll
                    for (int e = 0; e < 8; ++e) acc[e] += x[e] * cw[k][e]; } }
            u32x4 o; o.x = pk2(acc[0], acc[1]); o.y = pk2(acc[2], acc[3]); o.z = pk2(acc[4], acc[5]); o.w = pk2(acc[6], acc[7]);
            *(LAS u32x4*)(xcb + t * 72 + c8) = o; }
    }
    bf16x8 wrf[4][2], wif[4][2]; float sp4[4], br4[4], bi4[4];
    { const bf16_t* wT = (const bf16_t*)(p.ws + WS_LRUW) + ((size_t)(l * 8 + n) * 64) * 64;
#pragma unroll
        for (int nt = 0; nt < 4; ++nt) { const int d = nt * 16 + l15;
#pragma unroll
            for (int k = 0; k < 2; ++k) { wrf[nt][k] = *(const bf16x8*)(wT + d * 64 + k * 32 + 8 * lq); wif[nt][k] = *(const bf16x8*)(wT + 65536 + d * 64 + k * 32 + 8 * lq); }
            sp4[nt] = -8.f * 1.4426950408889634f * log1pf(__expf(-p.in[I_LAM][l * 512 + chn0 + d]));     br4[nt] = p.in[I_BR][l * 512 + chn0 + d]; bi4[nt] = p.in[I_BI][l * 512 + chn0 + d]; } }
    const size_t sbase = (size_t)b * 128 * 512 + chn0 + lane;
    float h = 0.f, P = 1.f;
    if (final) {
        int k = 0;
        for (; k + 32 <= ch; k += 32) { float pp[32], hh[32];
#pragma unroll
            for (int e = 0; e < 32; ++e) { pp[e] = Ps[sbase + (size_t)(k + e) * 512]; hh[e] = Hs[sbase + (size_t)(k + e) * 512]; }
#pragma unroll
            for (int e = 0; e < 32; ++e) h = pp[e] * h + hh[e]; }
        for (; k + 8 <= ch; k += 8) { float pp[8], hh[8];
#pragma unroll
            for (int e = 0; e < 8; ++e) { pp[e] = Ps[sbase + (size_t)(k + e) * 512]; hh[e] = Hs[sbase + (size_t)(k + e) * 512]; }
#pragma unroll
            for (int e = 0; e < 8; ++e) h = pp[e] * h + hh[e]; }
        for (; k < ch; ++k) h = Ps[sbase + (size_t)k * 512] * h + Hs[sbase + (size_t)k * 512];
    }
    bf16_t* gp = Z + (rowb + t0) * ZP + ZC_LRUG + chn0 + lane;
#pragma unroll 1
    for (int mt = 0; mt < 4; ++mt) {
        const bf16x8 a0 = *(const LAS bf16x8*)(xcb + (mt * 16 + l15) * 72 + 8 * lq), a1 = *(const LAS bf16x8*)(xcb + (mt * 16 + l15) * 72 + 32 + 8 * lq);
#pragma unroll
        for (int nt = 0; nt < 4; ++nt) {
            f32x4 ar = (f32x4){0.f, 0.f, 0.f, 0.f}, ai = (f32x4){0.f, 0.f, 0.f, 0.f};
            ar = __builtin_amdgcn_mfma_f32_16x16x32_bf16(a0, wrf[nt][0], ar, 0, 0, 0); ar = __builtin_amdgcn_mfma_f32_16x16x32_bf16(a1, wrf[nt][1], ar, 0, 0, 0);
            ai = __builtin_amdgcn_mfma_f32_16x16x32_bf16(a0, wif[nt][0], ai, 0, 0, 0); ai = __builtin_amdgcn_mfma_f32_16x16x32_bf16(a1, wif[nt][1], ai, 0, 0, 0);
            const int d = nt * 16 + l15;
#pragma unroll
            for (int j = 0; j < 4; ++j) { const int tl = 4 * lq + j;
                const float r = sigmoidf_(ar[j] + br4[nt]), ig = sigmoidf_(ai[j] + bi4[nt]);
                const float a = __builtin_amdgcn_exp2f(r * sp4[nt]);
                const float xcv = bf2f(xcb[(mt * 16 + tl) * 72 + d]);
                ab[tl * 64 + d] = a; ab[1024 + tl * 64 + d] = __builtin_amdgcn_sqrtf(fmaxf(1.f - a * a, 0.f)) * (ig * xcv); }
        }
        if (final) {
            unsigned g16[16];
#pragma unroll
            for (int tt = 0; tt < 16; ++tt) g16[tt] = gp[(size_t)(mt * 16 + tt) * ZP];
#pragma unroll
            for (int tt = 0; tt < 16; ++tt) { h = ab[tt * 64 + lane] * h + ab[1024 + tt * 64 + lane]; gp[(size_t)(mt * 16 + tt) * ZP] = (bf16_t)f2bf(h * bf2f(g16[tt])); }
        } else {
#pragma unroll
            for (int tt = 0; tt < 16; ++tt) { const float a = ab[tt * 64 + lane]; h = a * h + ab[1024 + tt * 64 + lane]; P *= a; }
        }
    }
    if (!final) { Ps[sbase + (size_t)ch * 512] = P; Hs[sbase + (size_t)ch * 512] = h; }
}

typedef float f32x16 __attribute__((ext_vector_type(16)));
typedef short s16x4 __attribute__((ext_vector_type(4)));
constexpr int AT_KROW = 208, AT_VOFF = 64 * AT_KROW, AT_STAGE = AT_VOFF + 8192;
constexpr int A2_VOFF = 128 * AT_KROW, A2_STAGE = A2_VOFF + 16384;
typedef __bf16 bf16x2_n __attribute__((ext_vector_type(2)));
__device__ __forceinline__ unsigned cvtpk2(float lo, float hi) { const f32x2 v = {lo, hi}; const bf16x2_n b = __builtin_convertvector(v, bf16x2_n); return __builtin_bit_cast(unsigned, b); }
__device__ __forceinline__ void a2_qk(const LAS unsigned char* kb, const bf16x8 (&qf)[6], const f32x16& cneg, f32x16& st0, f32x16& st1) {
    { const bf16x8 a0 = *(const LAS bf16x8*)(kb), a1 = *(const LAS bf16x8*)(kb + 32 * AT_KROW);
      st0 = __builtin_amdgcn_mfma_f32_32x32x16_bf16(a0, qf[0], cneg, 0, 0, 0); st1 = __builtin_amdgcn_mfma_f32_32x32x16_bf16(a1, qf[0], cneg, 0, 0, 0); }
#pragma unroll
    for (int s = 1; s < 6; ++s) { const bf16x8 a0 = *(const LAS bf16x8*)(kb + s * 32), a1 = *(const LAS bf16x8*)(kb + 32 * AT_KROW + s * 32);
        st0 = __builtin_amdgcn_mfma_f32_32x32x16_bf16(a0, qf[s], st0, 0, 0, 0); st1 = __builtin_amdgcn_mfma_f32_32x32x16_bf16(a1, qf[s], st1, 0, 0, 0); }
}
__device__ __forceinline__ bool a2_softmax(f32x16& st0, f32x16& st1, f32x16& ot0, f32x16& ot1, f32x16& cneg, float& mrun, float& lsum, bool first, bf16x8 (&pf)[4]) {
    float mt = fmaxf(st0[0], st1[0]);
#pragma unroll
    for (int r = 1; r < 16; ++r) mt = fmaxf(fmaxf(mt, st0[r]), st1[r]);
    mt = fmaxf(mt, __shfl_xor(mt, 32));
    const bool refresh = first || __builtin_amdgcn_ballot_w64(mt > 8.f) != 0ull;
    if (refresh) {
        const float delta = first ? mt : fmaxf(mt, 0.f), alpha = first ? 0.f : __builtin_amdgcn_exp2f(-delta);
        mrun += delta; lsum *= alpha;
#pragma unroll
        for (int r = 0; r < 16; ++r) { ot0[r] *= alpha; ot1[r] *= alpha; st0[r] -= delta; st1[r] -= delta; cneg[r] = -mrun; }
    }
    float ps = 0.f;
#pragma unroll
    for (int r = 0; r < 16; ++r) { st0[r] = __builtin_amdgcn_exp2f(st0[r]); st1[r] = __builtin_amdgcn_exp2f(st1[r]); ps += st0[r] + st1[r]; }
    lsum += ps;
    u32x4 w;
    w.x = cvtpk2(st0[0], st0[1]); w.y = cvtpk2(st0[2], st0[3]); w.z = cvtpk2(st0[4], st0[5]); w.w = cvtpk2(st0[6], st0[7]); pf[0] = __builtin_bit_cast(bf16x8, w);
    w.x = cvtpk2(st0[8], st0[9]); w.y = cvtpk2(st0[10], st0[11]); w.z = cvtpk2(st0[12], st0[13]); w.w = cvtpk2(st0[14], st0[15]); pf[1] = __builtin_bit_cast(bf16x8, w);
    w.x = cvtpk2(st1[0], st1[1]); w.y = cvtpk2(st1[2], st1[3]); w.z = cvtpk2(st1[4], st1[5]); w.w = cvtpk2(st1[6], st1[7]); pf[2] = __builtin_bit_cast(bf16x8, w);
    w.x = cvtpk2(st1[8], st1[9]); w.y = cvtpk2(st1[10], st1[11]); w.z = cvtpk2(st1[12], st1[13]); w.w = cvtpk2(st1[14], st1[15]); pf[3] = __builtin_bit_cast(bf16x8, w);
    return refresh;
}
__device__ __forceinline__ float a2_max(const f32x16& st0, const f32x16& st1) {
    float mt = fmaxf(st0[0], st1[0]);
#pragma unroll
    for (int r = 1; r < 16; ++r) mt = fmaxf(fmaxf(mt, st0[r]), st1[r]);
    return fmaxf(mt, __shfl_xor(mt, 32));
}
__device__ __forceinline__ void a2_exp_pack(f32x16& st0, f32x16& st1, float& lsum, bf16x8 (&pf)[4]) {
    float ps = 0.f;
#pragma unroll
    for (int r = 0; r < 16; ++r) { st0[r] = __builtin_amdgcn_exp2f(st0[r]); st1[r] = __builtin_amdgcn_exp2f(st1[r]); ps += st0[r] + st1[r]; }
    lsum += ps;
    u32x4 w;
    w.x = cvtpk2(st0[0], st0[1]); w.y = cvtpk2(st0[2], st0[3]); w.z = cvtpk2(st0[4], st0[5]); w.w = cvtpk2(st0[6], st0[7]); pf[0] = __builtin_bit_cast(bf16x8, w);
    w.x = cvtpk2(st0[8], st0[9]); w.y = cvtpk2(st0[10], st0[11]); w.z = cvtpk2(st0[12], st0[13]); w.w = cvtpk2(st0[14], st0[15]); pf[1] = __builtin_bit_cast(bf16x8, w);
    w.x = cvtpk2(st1[0], st1[1]); w.y = cvtpk2(st1[2], st1[3]); w.z = cvtpk2(st1[4], st1[5]); w.w = cvtpk2(st1[6], st1[7]); pf[2] = __builtin_bit_cast(bf16x8, w);
    w.x = cvtpk2(st1[8], st1[9]); w.y = cvtpk2(st1[10], st1[11]); w.z = cvtpk2(st1[12], st1[13]); w.w = cvtpk2(st1[14], st1[15]); pf[3] = __builtin_bit_cast(bf16x8, w);
}
__device__ __forceinline__ void a2_pv(const LAS unsigned char* vb, const bf16x8 (&pf)[4], f32x16& ot0, f32x16& ot1) {
#pragma unroll
    for (int s = 0; s < 4; ++s) {
        const s16x4 a00 = __builtin_bit_cast(s16x4, __builtin_amdgcn_ds_read_tr16_b64_v4i16((LAS s16x4*)(vb + (16 * s) * 64)));
        const s16x4 a01 = __builtin_bit_cast(s16x4, __builtin_amdgcn_ds_read_tr16_b64_v4i16((LAS s16x4*)(vb + (16 * s + 8) * 64)));
        const s16x4 a10 = __builtin_bit_cast(s16x4, __builtin_amdgcn_ds_read_tr16_b64_v4i16((LAS s16x4*)(vb + 8192 + (16 * s) * 64)));
        const s16x4 a11 = __builtin_bit_cast(s16x4, __builtin_amdgcn_ds_read_tr16_b64_v4i16((LAS s16x4*)(vb + 8192 + (16 * s + 8) * 64)));
        const bf16x8 va0 = (bf16x8){a00[0], a00[1], a00[2], a00[3], a01[0], a01[1], a01[2], a01[3]};
        const bf16x8 va1 = (bf16x8){a10[0], a10[1], a10[2], a10[3], a11[0], a11[1], a11[2], a11[3]};
        ot0 = __builtin_amdgcn_mfma_f32_32x32x16_bf16(va0, pf[s], ot0, 0, 0, 0); ot1 = __builtin_amdgcn_mfma_f32_32x32x16_bf16(va1, pf[s], ot1, 0, 0, 0); }
}
__device__ __forceinline__ void attn2_unit(bf16_t* Z, const bf16_t* Hb, const float* rc, const float* rs, LAS unsigned char* lds, int b, int h, int qblk) {
    const int tid = threadIdx.x, lane = tid & 63, wave = __builtin_amdgcn_readfirstlane(tid >> 6);
    const int l31 = lane & 31, hi = lane >> 5, l15 = lane & 15;
    const size_t rowb = (size_t)b * SEQ;
    const int q0 = qblk * 256 + wave * 32, cw = q0 >> 6, npairs = qblk * 2 + 2;
    bf16x8 qf[6];
    { const bf16_t* qp = Hb + (rowb + q0 + l31) * 1024 + h * 96 + 8 * hi;
#pragma unroll
        for (int s = 0; s < 6; ++s) qf[s] = *(const bf16x8*)(qp + 16 * s);
        const int pos = q0 + l31;
#pragma unroll
        for (int s = 4; s < 6; ++s) { const u32x4 raw = __builtin_bit_cast(u32x4, qf[s]); const int i0 = 8 * (s - 4) + 4 * hi;
            const f32x4 c = *(const f32x4*)(rc + pos * 16 + i0), sn = *(const f32x4*)(rs + pos * 16 + i0);
            u32x4 o;
            { const float x1 = bflo(raw.x), x2 = bfhi(raw.x); o.x = cvtpk2(x1 * c[0] - x2 * sn[0], x2 * c[0] + x1 * sn[0]); }
            { const float x1 = bflo(raw.y), x2 = bfhi(raw.y); o.y = cvtpk2(x1 * c[1] - x2 * sn[1], x2 * c[1] + x1 * sn[1]); }
            { const float x1 = bflo(raw.z), x2 = bfhi(raw.z); o.z = cvtpk2(x1 * c[2] - x2 * sn[2], x2 * c[2] + x1 * sn[2]); }
            { const float x1 = bflo(raw.w), x2 = bfhi(raw.w); o.w = cvtpk2(x1 * c[3] - x2 * sn[3], x2 * c[3] + x1 * sn[3]); }
            qf[s] = __builtin_bit_cast(bf16x8, o); } }
    const bf16_t* ksrc[4]; unsigned kstp[4]; const bf16_t* vsrc[2];
#pragma unroll
    for (int j = 0; j < 4; ++j) { const int pidx = (wave + 8 * j) * 64 + lane, key = (pidx / 13) & 127, c = pidx % 13, cc = c < 12 ? c : 0;
        ksrc[j] = cc < 8 ? Z + (rowb + key) * ZP + ZC_KN + h * 64 + cc * 8 : Hb + (rowb + key) * 1024 + 768 + (cc - 8) * 8;
        kstp[j] = cc < 8 ? 128u * ZP : 128u * 1024u; }
#pragma unroll
    for (int j = 0; j < 2; ++j) { const int pidx = (wave + 8 * j) * 64 + lane, dt = pidx >> 9, key = (pidx >> 2) & 127, cc = pidx & 3;
        vsrc[j] = Z + (rowb + key) * ZP + ZC_V + h * 64 + dt * 32 + cc * 8; }
    const int nkb = wave < 2 ? 4 : 3;
#define A2_STAGE_LOAD(stage_off, kpair) do { \
        _Pragma("unroll") for (int j = 0; j < 4; ++j) if (j < nkb) __builtin_amdgcn_global_load_lds((const unsigned*)(ksrc[j] + (size_t)(kpair) * kstp[j]), (LAS unsigned*)(lds + (stage_off) + (wave + 8 * j) * 1024), 16, 0, 0); \
        _Pragma("unroll") for (int j = 0; j < 2; ++j) __builtin_amdgcn_global_load_lds((const unsigned*)(vsrc[j] + (size_t)(kpair) * 128 * ZP), (LAS unsigned*)(lds + (stage_off) + A2_VOFF + (wave + 8 * j) * 1024), 16, 0, 0); } while (0)
    __syncthreads();
    A2_STAGE_LOAD(0, 0);
    __syncthreads();
    f32x16 ot0, ot1, cneg;
#pragma unroll
    for (int r = 0; r < 16; ++r) { ot0[r] = 0.f; ot1[r] = 0.f; cneg[r] = 0.f; }
    float mrun = 0.f, lsum = 0.f;
    const int kboff = l31 * AT_KROW + hi * 16;
    const int vboff = A2_VOFF + (4 * hi + (l15 >> 2)) * 64 + (16 * ((lane >> 4) & 1) + 4 * (l15 & 3)) * 2;
    for (int kp = 0; kp < npairs; ++kp) {
        const int sb = (kp & 1) * A2_STAGE, sbn = A2_STAGE - sb;
        const bool more = kp + 1 < npairs;
        if (more) A2_STAGE_LOAD(sbn, kp + 1);
        const LAS unsigned char* kb = lds + sb + kboff; const LAS unsigned char* vb = lds + sb + vboff;
        if (2 * kp + 1 <= cw) {
            f32x16 sa0, sa1, sb0, sb1; bf16x8 pa[4], pb[4];
            __builtin_amdgcn_s_setprio(1);
            a2_qk(kb, qf, cneg, sa0, sa1);
            a2_qk(kb + 64 * AT_KROW, qf, cneg, sb0, sb1);
            __builtin_amdgcn_s_setprio(0);
            const float mt = fmaxf(a2_max(sa0, sa1), a2_max(sb0, sb1));
            if (kp == 0 || __builtin_amdgcn_ballot_w64(mt > 8.f) != 0ull) {
                const float delta = (kp == 0) ? mt : fmaxf(mt, 0.f), alpha = (kp == 0) ? 0.f : __builtin_amdgcn_exp2f(-delta);
                mrun += delta; lsum *= alpha;
#pragma unroll
                for (int r = 0; r < 16; ++r) { ot0[r] *= alpha; ot1[r] *= alpha; sa0[r] -= delta; sa1[r] -= delta; sb0[r] -= delta; sb1[r] -= delta; cneg[r] = -mrun; }
            }
            a2_exp_pack(sa0, sa1, lsum, pa);
            a2_pv(vb, pa, ot0, ot1);
            a2_exp_pack(sb0, sb1, lsum, pb);
            a2_pv(vb + 64 * 64, pb, ot0, ot1);
        } else if (2 * kp <= cw) {
            f32x16 sa0, sa1; bf16x8 pa[4];
            a2_qk(kb, qf, cneg, sa0, sa1);
            const float mt = a2_max(sa0, sa1);
            if (kp == 0 || __builtin_amdgcn_ballot_w64(mt > 8.f) != 0ull) {
                const float delta = (kp == 0) ? mt : fmaxf(mt, 0.f), alpha = (kp == 0) ? 0.f : __builtin_amdgcn_exp2f(-delta);
                mrun += delta; lsum *= alpha;
#pragma unroll
                for (int r = 0; r < 16; ++r) { ot0[r] *= alpha; ot1[r] *= alpha; sa0[r] -= delta; sa1[r] -= delta; cneg[r] = -mrun; }
            }
            a2_exp_pack(sa0, sa1, lsum, pa);
            a2_pv(vb, pa, ot0, ot1);
        }
        __syncthreads();
    }
    lsum += __shfl_xor(lsum, 32);
    const float inv = 1.f / lsum;
    bf16_t* op = Z + (rowb + q0 + l31) * ZP + ZC_YB + h * 64 + 4 * hi;
#pragma unroll
    for (int g4 = 0; g4 < 4; ++g4) {
        u32x2 w0; w0.x = cvtpk2(ot0[4 * g4] * inv, ot0[4 * g4 + 1] * inv); w0.y = cvtpk2(ot0[4 * g4 + 2] * inv, ot0[4 * g4 + 3] * inv); *(u32x2*)(op + 8 * g4) = w0;
        u32x2 w1; w1.x = cvtpk2(ot1[4 * g4] * inv, ot1[4 * g4 + 1] * inv); w1.y = cvtpk2(ot1[4 * g4 + 2] * inv, ot1[4 * g4 + 3] * inv); *(u32x2*)(op + 32 + 8 * g4) = w1; }
}

#ifndef PHMASK
#define PHMASK 0xFFFF
#endif
#define PHON(k) ((PHMASK >> (k)) & 1)
constexpr int NPHASE = 24;
template <int ph>
__device__ __forceinline__ void run_phase(const Params& p, unsigned char* lds, const int vc, const LnRows lnl) {
    unsigned char* ws = p.ws;
    const int G = gridDim.x, bx = vc;
    const LnRows lng{(int)blockIdx.x * 8 + (int)(threadIdx.x >> 6), (int)gridDim.x * 8, 0, T};
    bf16_t* Hb = (bf16_t*)(ws + WS_H); bf16_t* Z = (bf16_t*)(ws + WS_Z);
    float* X = p.out;
    const float* mod = (const float*)(ws + WS_MOD);
    LAS unsigned char* ldsl = (LAS unsigned char*)lds;
    {
        if (ph == 0) { if (PHON(12)) prologue<0>(p, lds); }
        else if (ph == NPHASE - 1) { if (PHON(0)) ln_pass(X, X, p.in[I_LNG] + (1 * 2 + 1) * DM, p.in[I_LNB] + (1 * 2 + 1) * DM, nullptr, nullptr, nullptr, nullptr, lnl); }
        else {
            const int l = (ph - 1) / 11, sp = (ph - 1) % 11;
            const float* modl = mod + l * 4 * 6144;
            if (sp == 0 && PHON(0)) {
                if (l == 0) { prologue<1>(p, lds); ln_pass(p.in[I_X], nullptr, nullptr, nullptr, modl + 1 * 1024, modl + 0 * 1024, Hb, nullptr, lng); }
                else ln_pass(X, nullptr, p.in[I_LNG] + (0 * 2 + 1) * DM, p.in[I_LNB] + (0 * 2 + 1) * DM, modl + 1 * 1024, modl + 0 * 1024, Hb, (float*)(ws + WS_STAT) + 2 * T, lnl);
            } else if (sp == 1 && PHON(1)) {
                pg8::Gemm g{Hb, (const bf16_t*)(ws + WS_WIN) + (size_t)l * ZP * 1024, 1024, 1024}; pg8::StaticOrder S; S.init(T, ZP, G, bx);
                pg8::EpiZ E{Z, (const float*)(ws + WS_BIASP) + l * ZP};
                pg8::gemm_phase<pg8::EpiZ, pg8::StaticOrder>(ldsl, g, S, E);
            } else if (sp == 2 && PHON(2)) {
                for (int u = bx; u < 256; u += G) gmlp_mfma_unit(p, l, Z, ldsl, u);
                latent_pass(p, l, Z, Hb);
                __syncthreads();
                if (lnl.ngw == 256) {
                    const int lw = __builtin_amdgcn_readfirstlane(lnl.gw), xx = lnl.rbase >> 12;
                    for (int k = 0; k < 2; ++k) { const int id = lw + 256 * k, combo = 4 * xx + (id >> 7);
                        lru_wave_unit(p, l, Z, ldsl + __builtin_amdgcn_readfirstlane(threadIdx.x >> 6) * 17408, combo >> 3, k ? 127 - (id & 127) : (id & 127), combo & 7, 0); }
                } else
                for (int u = bx * 8 + __builtin_amdgcn_readfirstlane(threadIdx.x >> 6); u < 4096; u += G * 8) lru_wave_unit(p, l, Z, ldsl + __builtin_amdgcn_readfirstlane(threadIdx.x >> 6) * 17408, u >> 10, (u >> 3) & 127, u & 7, 0);
            } else if (sp == 3 && PHON(3)) {
                if (lnl.ngw == 256) {
                    const int lw = __builtin_amdgcn_readfirstlane(lnl.gw), xx = lnl.rbase >> 12;
                    for (int k = 0; k < 2; ++k) { const int id = lw + 256 * k, combo = 4 * xx + (id >> 7);
                        lru_wave_unit(p, l, Z, ldsl + __builtin_amdgcn_readfirstlane(threadIdx.x >> 6) * 17408, combo >> 3, k ? 127 - (id & 127) : (id & 127), combo & 7, 1); }
                } else
                for (int u = bx * 8 + __builtin_amdgcn_readfirstlane(threadIdx.x >> 6); u < 4096; u += G * 8) lru_wave_unit(p, l, Z, ldsl + __builtin_amdgcn_readfirstlane(threadIdx.x >> 6) * 17408, u >> 10, (u >> 3) & 127, u & 7, 1);
            } else if (sp == 4 && PHON(4)) {
                pg8::Gemm g{Z + ZC_QLAT, (const bf16_t*)(ws + WS_WUP) + (size_t)l * NUP * KUP, ZP, KUP}; pg8::StaticOrder S; S.init(T, NUP, G, bx);
                pg8::EpiUp E{Hb, Z};
                pg8::gemm_phase<pg8::EpiUp, pg8::StaticOrder>(ldsl, g, S, E);
            } else if (sp == 5 && PHON(5)) {
                const float* rc = (const float*)(ws + WS_ROPE); const float* rs = rc + SEQ * 16;
                if (G == 256) {
                    const int x = bx & 7, j = bx >> 3;
                    for (int r = 0; r < 2; ++r) { const int bh = 4 * x + 2 * r + (j >> 4), pp = j & 15;
                        attn2_unit(Z, Hb, rc, rs, ldsl, bh >> 3, bh & 7, 31 - pp);
                        attn2_unit(Z, Hb, rc, rs, ldsl, bh >> 3, bh & 7, pp); }
                } else {
                    for (int w = bx; w < 512; w += G) { const int bh = w >> 4, pp = w & 15;
                        attn2_unit(Z, Hb, rc, rs, ldsl, bh >> 3, bh & 7, 31 - pp);
                        attn2_unit(Z, Hb, rc, rs, ldsl, bh >> 3, bh & 7, pp); }
                }
            } else if (sp == 6 && PHON(6)) {
                pg8::Gemm g{Z, (const bf16_t*)(ws + WS_WBR) + (size_t)l * 3072 * 512, ZP, 512}; pg8::BranchOrder S{G, bx, lnl.ngw == 256 ? 1 : 0, lnl.rbase >> 12, __builtin_amdgcn_readfirstlane(lnl.gw) >> 3};
                pg8::EpiBranch E{Hb, Z};
                pg8::gemm_phase<pg8::EpiBranch, pg8::BranchOrder>(ldsl, g, S, E);
            } else if (sp == 7 && PHON(7)) {
                pg8::Gemm g{Hb, (const bf16_t*)(ws + WS_WMIX) + (size_t)l * 1024 * 1024, 1024, 1024}; pg8::StaticOrder S; S.init(T, DM, G, bx);
                pg8::EpiRes E{l == 0 ? p.in[I_X] : X, X, modl + 2 * 1024, nullptr, l == 0 ? nullptr : (const float*)(ws + WS_STAT) + 2 * T, p.in[I_LNG] + (0 * 2 + 1) * DM, p.in[I_LNB] + (0 * 2 + 1) * DM};
                pg8::gemm_phase<pg8::EpiRes, pg8::StaticOrder>(ldsl, g, S, E);
            } else if (sp == 8 && PHON(8)) {
                ln_pass(X, nullptr, p.in[I_LNG] + (l * 2 + 0) * DM, p.in[I_LNB] + (l * 2 + 0) * DM, modl + 4 * 1024, modl + 3 * 1024, Hb, (float*)(ws + WS_STAT), lnl);
            } else if (sp == 9 && PHON(9)) {
                pg8::Gemm g{Hb, (const bf16_t*)(ws + WS_W1) + (size_t)l * FF * 1024, 1024, 1024}; pg8::StaticOrder S; S.init(T, FF, G, bx);
                pg8::EpiFF1 E{Z, p.in[I_B1] + l * FF};
                pg8::gemm_phase<pg8::EpiFF1, pg8::StaticOrder>(ldsl, g, S, E);
            } else if (PHON(10)) {
                pg8::Gemm g{Z, (const bf16_t*)(ws + WS_W2) + (size_t)l * 1024 * FF, ZP, FF}; pg8::StaticOrder S; S.init(T, DM, G, bx);
                pg8::EpiRes E{X, X, modl + 5 * 1024, p.in[I_B2] + l * DM, (const float*)(ws + WS_STAT), p.in[I_LNG] + (l * 2 + 0) * DM, p.in[I_LNB] + (l * 2 + 0) * DM};
                pg8::gemm_phase<pg8::EpiRes, pg8::StaticOrder>(ldsl, g, S, E);
            }
        }
    }
}
__global__ void __launch_bounds__(NTHREADS, 2) fwd_kernel(Params p) {
    extern __shared__ __attribute__((aligned(16))) unsigned char lds[];
    cg::grid_group grid = cg::this_grid();
    volatile LAS unsigned* bst = (volatile LAS unsigned*)((LAS unsigned char*)lds + LDS_BYTES - 16);
    if (threadIdx.x == 0) { bst[0] = 0u; bst[1] = 0u; }
    __syncthreads();
    volatile LAS unsigned* bst2 = (volatile LAS unsigned*)((LAS unsigned char*)lds + LDS_BYTES - 32);
    XcdBarrier xbar; xbar.bar = (unsigned*)(p.ws + WS_BAR); xbar.x = xb_xcc_id(); xbar.st = bst;
    if (threadIdx.x == 0) bst2[0] = xb_add(&xbar.bar[XB_XCNT(xbar.x)], 1u);
    __syncthreads();
    const int xrank = (int)bst2[0];
    int vc = blockIdx.x, use_local = 0;
    LnRows lnl{(int)blockIdx.x * 8 + (int)(threadIdx.x >> 6), (int)gridDim.x * 8, 0, T};
#define GSYNC(PH) do { if ((PH) == 0) grid.sync(); else if (use_local && ((PH) == 3 || (PH) == 14 || (PH) == 7 || (PH) == 18 || (PH) == 8 || (PH) == 9 || (PH) == 10 || (PH) == 11 || (PH) == 12 || (PH) == 19 || (PH) == 20 || (PH) == 21 || (PH) == 22)) xcd_local_barrier(xbar); else xcd_barrier(xbar); \
    if ((PH) == 1) { if (threadIdx.x == 0 && !(gridDim.x == 256 && bst[0] == 32u && bst[1] == 8u && xbar.x < 8u && xrank < 32)) xb_add(&xbar.bar[XB_BAD], 1u); } \
    if ((PH) == 2) { if (threadIdx.x == 0) bst2[1] = (xb_ld(&xbar.bar[XB_BAD]) == 0u) ? 1u : 0u; __syncthreads(); use_local = (int)bst2[1]; \
        if (use_local) { vc = xrank * 8 + (int)xbar.x; lnl = LnRows{xrank * 8 + (int)(threadIdx.x >> 6), 256, (int)xbar.x * 4096, (int)xbar.x * 4096 + 4096}; } } } while (0)
#ifndef XSYNC
#define XSYNC 0
#endif
#ifndef REPPH
#define REPPH -1
#endif
#ifndef REPSP
#define REPSP -1
#endif
#define RUN(PH) if (p.ph_lo <= PH && PH < p.ph_hi) { run_phase<PH>(p, lds, vc, lnl); if (PH > 0 && PH < 23 && (PH - 1) % 11 == REPSP) { GSYNC(PH); run_phase<PH>(p, lds, vc, lnl); } if (PH + 1 < p.ph_hi) { GSYNC(PH); if (XSYNC) GSYNC(PH); } if (PH == REPPH) { run_phase<PH>(p, lds, vc, lnl); GSYNC(PH); } }
    RUN(0) RUN(1) RUN(2) RUN(3) RUN(4) RUN(5) RUN(6) RUN(7) RUN(8) RUN(9) RUN(10) RUN(11)
    RUN(12) RUN(13) RUN(14) RUN(15) RUN(16) RUN(17) RUN(18) RUN(19) RUN(20) RUN(21) RUN(22) RUN(23)
#undef RUN
}

extern "C" void kernel_launch(void* const* d_in, const int* in_sizes, int n_in, void* d_out, int out_size, void* d_ws, size_t ws_size, hipStream_t stream) {
    static int grid = 0;
    if (grid == 0) {
        if (n_in != 29 || out_size != T * DM || ws_size < WS_END) { fprintf(stderr, "kernel_launch: unexpected sizes n_in %d out %d ws %zu (need %zu)\n", n_in, out_size, ws_size, (size_t)WS_END); grid = -1; return; }
        int dev = 0, cus = 0, per_cu = 0;
        hipGetDevice(&dev); hipDeviceGetAttribute(&cus, hipDeviceAttributeMultiprocessorCount, dev);
        if (hipFuncSetAttribute((const void*)fwd_kernel, hipFuncAttributeMaxDynamicSharedMemorySize, LDS_BYTES) != hipSuccess) { fprintf(stderr, "kernel_launch: hipFuncSetAttribute failed\n"); grid = -1; return; }
        if (hipOccupancyMaxActiveBlocksPerMultiprocessor(&per_cu, (const void*)fwd_kernel, NTHREADS, LDS_BYTES) != hipSuccess || per_cu < 1) { fprintf(stderr, "kernel_launch: occupancy query says %d\n", per_cu); per_cu = 1; }
        (void)hipGetLastError();
        grid = cus * 1;
        fprintf(stderr, "kernel_launch: grid %d (cus %d, per_cu %d), ws %zu\n", grid, cus, per_cu, ws_size);
    }
    if (grid < 0) return;
    if (hipMemsetAsync((char*)d_ws + WS_BAR, 0, 16384, stream) != hipSuccess) { fprintf(stderr, "kernel_launch: memset failed\n"); return; }
    Params p{};
    for (int i = 0; i < 29; ++i) p.in[i] = (const float*)d_in[i];
    p.out = (float*)d_out; p.ws = (unsigned char*)d_ws; p.ph_lo = 0; p.ph_hi = NPHASE;
    void* args[] = {&p};
    hipError_t e = hipLaunchCooperativeKernel((const void*)fwd_kernel, dim3(grid), dim3(NTHREADS), args, LDS_BYTES, stream);
    if (e != hipSuccess) fprintf(stderr, "kernel_launch: cooperative launch failed: %s (grid %d)\n", hipGetErrorString(e), grid);
}
```
